# Optimizing an MI355X kernel written in HIP

```python
import math
import jax, jax.numpy as jnp
from jax import lax
import numpy as np

D_MODEL = 2048
BATCH = 8
SEQ = 2048
DEPTH = 1

HEAD_DIM = 64
N_HEADS_SWA = 16
N_KV_SWA = 4
N_HEADS_SB = 16
WINDOW = 128
BLOCK = 128
MEM_LEN = 256
N_HEADS_MEM = 4
HEAD_DIM_MEM = D_MODEL // N_HEADS_MEM
D_SWA = N_HEADS_SWA * HEAD_DIM
D_KV_SWA = N_KV_SWA * HEAD_DIM
D_SB = N_HEADS_SB * HEAD_DIM
D_MIX = D_SWA + D_SB
D_IN = D_SWA + 2 * D_KV_SWA + 3 * D_SB
D_FF = -(-8 * D_MODEL // (3 * 256)) * 256
ALPHA = (2.0 * DEPTH) ** 0.25
BETA = (8.0 * DEPTH) ** -0.25
LN_EPS = 1e-5
RMS_EPS = 1e-6

kernel_name = "hymba_swa_sink_stickbreak_deepnorm_layer"


def _alibi_slopes(n):
    return jnp.asarray(2.0 ** (-8.0 * np.arange(1, n + 1) / n), dtype=jnp.float32)


def layer_norm(x, g, b):
    xf = x.astype(jnp.float32)
    mu = jnp.mean(xf, axis=-1, keepdims=True)
    var = jnp.mean(jnp.square(xf - mu), axis=-1, keepdims=True)
    y = (xf - mu) * lax.rsqrt(var + LN_EPS)
    return (y * g.astype(jnp.float32) + b.astype(jnp.float32)).astype(x.dtype)


def head_rmsnorm(o, g):
    H, D = o.shape[-2:]
    of = o.astype(jnp.float32)
    y = of * lax.rsqrt(jnp.mean(jnp.square(of), axis=-1, keepdims=True) + RMS_EPS)
    return (y * g.reshape(H, D).astype(jnp.float32)).astype(o.dtype)


def swa_sink_attention(q, k, v, sinks):
    B, S, HQ, D = q.shape
    HKV = k.shape[2]
    G = HQ // HKV
    nb = S // BLOCK
    qb = q.reshape(B, nb, BLOCK, HKV, G, D)

    def band(t):
        tb = t.reshape(B, nb, BLOCK, HKV, D)
        prev = jnp.pad(tb, ((0, 0), (1, 0), (0, 0), (0, 0), (0, 0)))[:, :-1]
        return jnp.concatenate([prev, tb], axis=2)

    kb, vb = band(k), band(v)
    scores = jnp.einsum('bnqkgd,bnskd->bnkgqs', qb, kb).astype(jnp.float32) / math.sqrt(D)
    qi = jnp.arange(BLOCK)[:, None]
    kj = jnp.arange(2 * BLOCK)[None, :]
    dist = qi + BLOCK - kj
    key_pos = jnp.arange(nb)[:, None, None] * BLOCK - BLOCK + kj
    valid = (dist >= 0) & (dist < WINDOW) & (key_pos >= 0)
    slopes = _alibi_slopes(HQ).reshape(HKV, G)
    scores = scores - slopes[None, None, :, :, None, None] * dist.astype(jnp.float32)
    scores = jnp.where(valid[None, :, None, None], scores, -jnp.inf)
    sink = sinks.astype(jnp.float32).reshape(HKV, G)[None, None, :, :, None, None]
    m = jnp.maximum(jnp.max(scores, axis=-1, keepdims=True), sink)
    p = jnp.exp(scores - m)
    denom = jnp.sum(p, axis=-1, keepdims=True) + jnp.exp(sink - m)
    out = jnp.einsum('bnkgqs,bnskd->bnqkgd', (p / denom).astype(v.dtype), vb)
    return out.reshape(B, S, HQ, D)


def stick_breaking_attention(q, k, v):
    B, S, H, D = q.shape
    nb = S // BLOCK
    outs = []
    for n in range(nb):
        t0, t1 = n * BLOCK, (n + 1) * BLOCK
        kn, vn = k[:, :t1], v[:, :t1]
        z = jnp.einsum('bqhd,bshd->bhqs', q[:, t0:t1], kn).astype(jnp.float32) / math.sqrt(D)
        causal = jnp.arange(t1)[None, :] < (t0 + jnp.arange(BLOCK))[:, None]
        log_beta = jax.nn.log_sigmoid(z)
        log_1m = jnp.where(causal, jax.nn.log_sigmoid(-z), 0.0)
        between = lax.cumsum(log_1m, axis=log_1m.ndim - 1, reverse=True) - log_1m
        a = jnp.where(causal, jnp.exp(log_beta + between), 0.0)
        outs.append(jnp.einsum('bhqs,bshd->bqhd', a.astype(v.dtype), vn))
    return jnp.concatenate(outs, axis=1)


def memory_cross_attention(h, mem, w_q, w_kv, w_o):
    B, S, _ = h.shape
    q = (h @ w_q).reshape(B, S, N_HEADS_MEM, HEAD_DIM_MEM)
    k, v = jnp.split(mem @ w_kv, 2, axis=-1)
    k = k.reshape(B, -1, N_HEADS_MEM, HEAD_DIM_MEM)
    v = v.reshape(B, -1, N_HEADS_MEM, HEAD_DIM_MEM)
    s = jnp.einsum('bqhd,bmhd->bhqm', q, k).astype(jnp.float32) / math.sqrt(HEAD_DIM_MEM)
    p = jax.nn.softmax(s, axis=-1).astype(v.dtype)
    o = jnp.einsum('bhqm,bmhd->bqhd', p, v).reshape(B, S, D_MODEL)
    return o @ w_o


def setup_inputs(seed: int = 0) -> dict:
    key = jax.random.key(seed)
    ks = jax.random.split(key, 20)
    f32 = jnp.float32

    def nrm(k, shape, scale):
        return jax.random.normal(k, shape, f32) * scale

    d = D_MODEL
    col_scale = jnp.concatenate([
        jnp.ones((D_SWA + D_KV_SWA,), f32), jnp.full((D_KV_SWA,), BETA, f32),
        jnp.ones((2 * D_SB,), f32), jnp.full((D_SB,), BETA, f32)])
    kv_scale = jnp.concatenate([jnp.ones((d,), f32), jnp.full((d,), BETA, f32)])
    return {
        "x": jax.random.normal(ks[0], (BATCH, SEQ, d), f32),
        "mem": jax.random.normal(ks[1], (BATCH, MEM_LEN, d), f32),
        "w_in": nrm(ks[2], (DEPTH, d, D_IN), d ** -0.5) * col_scale,
        "sinks": nrm(ks[3], (DEPTH, N_HEADS_SWA), 0.5),
        "g_swa": 1.0 + nrm(ks[4], (DEPTH, D_SWA), 0.02),
        "g_sb": 1.0 + nrm(ks[5], (DEPTH, D_SB), 0.02),
        "w_o": nrm(ks[6], (DEPTH, D_MIX, d), BETA * D_MIX ** -0.5),
        "ln1_g": 1.0 + nrm(ks[7], (DEPTH, d), 0.02),
        "ln1_b": nrm(ks[8], (DEPTH, d), 0.02),
        "w_q_mem": nrm(ks[9], (DEPTH, d, d), d ** -0.5),
        "w_kv_mem": nrm(ks[10], (DEPTH, d, 2 * d), d ** -0.5) * kv_scale,
        "w_o_mem": nrm(ks[11], (DEPTH, d, d), BETA * d ** -0.5),
        "ln2_g": 1.0 + nrm(ks[12], (DEPTH, d), 0.02),
        "ln2_b": nrm(ks[13], (DEPTH, d), 0.02),
        "w_gate_up": nrm(ks[14], (DEPTH, d, 2 * D_FF), d ** -0.5),
        "w_down": nrm(ks[15], (DEPTH, D_FF, d), BETA * D_FF ** -0.5),
        "ln3_g": 1.0 + nrm(ks[16], (DEPTH, d), 0.02),
        "ln3_b": nrm(ks[17], (DEPTH, d), 0.02),
    }


def reference(x, mem, w_in, sinks, g_swa, g_sb, w_o, ln1_g, ln1_b, w_q_mem, w_kv_mem,
              w_o_mem, ln2_g, ln2_b, w_gate_up, w_down, ln3_g, ln3_b):
    B, S, _ = x.shape
    splits = np.cumsum([D_SWA, D_KV_SWA, D_KV_SWA, D_SB, D_SB]).tolist()
    h = x
    for l in range(DEPTH):
        q_a, k_a, v_a, q_b, k_b, v_b = jnp.split(h @ w_in[l], splits, axis=-1)
        o_a = swa_sink_attention(
            q_a.reshape(B, S, N_HEADS_SWA, HEAD_DIM),
            k_a.reshape(B, S, N_KV_SWA, HEAD_DIM),
            v_a.reshape(B, S, N_KV_SWA, HEAD_DIM), sinks[l])
        o_b = stick_breaking_attention(
            q_b.reshape(B, S, N_HEADS_SB, HEAD_DIM),
            k_b.reshape(B, S, N_HEADS_SB, HEAD_DIM),
            v_b.reshape(B, S, N_HEADS_SB, HEAD_DIM))
        o_a = head_rmsnorm(o_a, g_swa[l]).reshape(B, S, D_SWA)
        o_b = head_rmsnorm(o_b, g_sb[l]).reshape(B, S, D_SB)
        mix = jnp.concatenate([o_a, o_b], axis=-1) @ w_o[l]
        h = layer_norm(ALPHA * h + mix, ln1_g[l], ln1_b[l])
        c = memory_cross_attention(h, mem, w_q_mem[l], w_kv_mem[l], w_o_mem[l])
        h = layer_norm(ALPHA * h + c, ln2_g[l], ln2_b[l])
        gate, up = jnp.split(h @ w_gate_up[l], 2, axis=-1)
        f = (jax.nn.silu(gate) * up) @ w_down[l]
        h = layer_norm(ALPHA * h + f, ln3_g[l], ln3_b[l])
    return h
```

```cpp
#include <hip/hip_runtime.h>
#include <hip/hip_cooperative_groups.h>
#include <cstdio>
#include <cstdint>
namespace cg = cooperative_groups;

#ifndef PROBE_DUP
#define PROBE_DUP 0
#endif
#ifndef MK_MULTI
#define MK_MULTI 0
#endif

#define LAS __attribute__((address_space(3)))
typedef unsigned short bf16_t;
typedef short bf16x8 __attribute__((ext_vector_type(8)));
typedef short s16x4 __attribute__((ext_vector_type(4)));
typedef float f32x4 __attribute__((ext_vector_type(4)));
typedef float f32x2 __attribute__((ext_vector_type(2)));
typedef float f32x16 __attribute__((ext_vector_type(16)));
typedef unsigned u32x4 __attribute__((ext_vector_type(4)));
typedef unsigned u32x2 __attribute__((ext_vector_type(2)));

constexpr int DM = 2048, NB = 8, SEQ = 2048, MTOK = NB * SEQ;
constexpr int MEML = 256, MROWS = NB * MEML;
constexpr int D_IN = 4608, D_FF = 5632, NQK = 3328, NVT = 1280;
constexpr float ALPHA = 1.189207115002721f;
constexpr float LN_EPS = 1e-5f, RMS_EPS = 1e-6f;
constexpr float LOG2E = 1.4426950408889634f;
constexpr int NPHASE = 13, NCS = 2048 + 11264;

constexpr size_t MiB = 1u << 20;
constexpr size_t WS_QK = 0;
constexpr size_t WS_VT = 104 * MiB;
constexpr size_t WS_QM = 0;
constexpr size_t WS_P = 64 * MiB;
constexpr size_t WS_OC = 96 * MiB;
constexpr size_t WS_F = 0;
constexpr size_t WS_Y = 176 * MiB;
constexpr size_t WS_ALL = 304 * MiB;
constexpr size_t WS_KM = 160 * MiB;
constexpr size_t WS_VMT = 168 * MiB;
constexpr size_t WS_WO = 410 * MiB, WS_WQM = 418 * MiB, WS_WOM = 426 * MiB;
constexpr size_t WS_WGU = 434 * MiB;
constexpr size_t WS_WD = 478 * MiB;
constexpr size_t WS_CTL = 500 * MiB, CTL_BYTES = 64 * 1024;
constexpr size_t WS_CSP = 501 * MiB;
constexpr size_t WS_CSF = 505 * MiB;
constexpr size_t WS_SP1 = 368 * MiB, WS_SP2 = 372 * MiB;
constexpr size_t WS_END = 506 * MiB;

typedef __bf16 bf16x2_t __attribute__((ext_vector_type(2)));
__device__ __forceinline__ unsigned cvt_pk_bf16(float lo, float hi) { const f32x2 v = {lo, hi}; const bf16x2_t b = __builtin_convertvector(v, bf16x2_t); return __builtin_bit_cast(unsigned, b); }
__device__ __forceinline__ float fexp2(float x) { return __builtin_amdgcn_exp2f(x); }
__device__ __forceinline__ float flog2(float x) { return __builtin_amdgcn_logf(x); }
__device__ __forceinline__ float wave_sum(float v) {
#pragma unroll
    for (int o = 1; o < 64; o <<= 1) v += __shfl_xor(v, o);
    return v;
}
#define LDS_WAIT() asm volatile("s_waitcnt lgkmcnt(0)" ::: "memory")

namespace pg8 {
constexpr int BM = 256, BK = 64, HALF = 128, HTB = HALF * BK * 2, STAGE_BYTES = 8 * HTB, NXCD = 8, WGM = 8;
__host__ __device__ __forceinline__ int lds_byte(int r, int c) { const int st = (r >> 4) * 2 + (c >> 5), rr = r & 15, cc = c & 31, ob = rr * 64 + cc * 2; return st * 1024 + (ob ^ (((ob >> 9) & 1) << 5)); }
__host__ __device__ __forceinline__ void stage_rc(int b, int& R, int& C) { const int st = b / 1024, sb = b % 1024, swz = sb ^ (((sb >> 9) & 1) << 5); R = (st >> 1) * 16 + swz / 64; C = (st & 1) * 32 + (swz % 64) / 2; }
__host__ __device__ __forceinline__ int perm32(int rho) { const int n = rho >> 4, i = rho & 15; return 8 * (i >> 2) + 4 * n + (i & 3); }

struct Unit { int pm, pn, z; };

__device__ __forceinline__ void map_tile(int l, int nM, int nN, int& pm, int& pn) {
    const int nwg = nM * nN; int wgid = l;
    { const int q = nwg / NXCD, r = nwg % NXCD, xcd = wgid % NXCD, off = wgid / NXCD; wgid = (xcd < r ? xcd * (q + 1) : r * (q + 1) + (xcd - r) * q) + off; }
    const int nig = WGM * nN, gid = wgid / nig, fm = gid * WGM, gsz = (nM - fm) < WGM ? (nM - fm) : WGM;
    pm = fm + ((wgid % nig) % gsz); pn = (wgid % nig) / gsz;
}

struct SchedPlain {
    const char* A; const char* Bt; int nM, nN, G, c; size_t tA, tB;
    __device__ void init(const bf16_t* A_, int lda, const bf16_t* B_, int ldb, int M, int N, int G_, int c_) { A = (const char*)A_; Bt = (const char*)B_; nM = M / BM; nN = N / BM; G = G_; c = c_; tA = (size_t)BM * lda * 2; tB = (size_t)BM * ldb * 2; }
    __device__ __forceinline__ bool next(int i, Unit& u) const { const long L = (long)i * G + c; if (L >= (long)nM * nN) return false; map_tile((int)L, nM, nN, u.pm, u.pn); u.z = 0; return true; }
    __device__ __forceinline__ const char* pa(const Unit& u) const { return A + (size_t)u.pm * tA; }
    __device__ __forceinline__ const char* pb(const Unit& u) const { return Bt + (size_t)u.pn * tB; }
};

struct SchedP1 {
    const char* all; int G, c;
    static constexpr size_t TB = (size_t)BM * DM * 2;
    __device__ __forceinline__ bool next(int i, Unit& u) const {
        const long L = (long)i * G + c; if (L >= 1280) return false;
        int l = (int)L;
        if (l < 832) { u.z = 0; map_tile(l, 64, 13, u.pm, u.pn); }
        else if (l < 1152) { u.z = 1; map_tile(l - 832, 5, 64, u.pm, u.pn); }
        else if (l < 1216) { u.z = 2; map_tile(l - 1152, 8, 8, u.pm, u.pn); }
        else { u.z = 3; map_tile(l - 1216, 8, 8, u.pm, u.pn); }
        return true;
    }
    __device__ __forceinline__ const char* pa(const Unit& u) const {
        const int t = u.z == 0 ? u.pm : (u.z == 1 ? 72 + (u.pm == 0 ? 5 : 13 + u.pm) : (u.z == 2 ? 64 + u.pm : 98 + u.pm));
        return all + (size_t)t * TB;
    }
    __device__ __forceinline__ const char* pb(const Unit& u) const {
        const int t = u.z == 0 ? 72 + (u.pn < 5 ? u.pn : u.pn + 1) : (u.z == 1 ? u.pn : (u.z == 2 ? 90 + u.pn : 64 + u.pn));
        return all + (size_t)t * TB;
    }
};

struct SchedQK {
    const char* Qm; const char* Km; int G, c;
    __device__ __forceinline__ bool next(int i, Unit& u) const { const long L = (long)i * G + c; if (L >= 256) return false; u.z = (int)L >> 3; u.pm = (int)L & 7; u.pn = 0; return true; }
    __device__ __forceinline__ const char* pa(const Unit& u) const { const int b = u.z >> 2, h = u.z & 3; return Qm + ((size_t)(b * SEQ + u.pm * 256) * DM + h * 512) * 2; }
    __device__ __forceinline__ const char* pb(const Unit& u) const { const int b = u.z >> 2, h = u.z & 3; return Km + ((size_t)(b * MEML) * DM + h * 512) * 2; }
};
struct SchedPV {
    const char* P; const char* Vt; int G, c;
    __device__ __forceinline__ bool next(int i, Unit& u) const { const long L = (long)i * G + c; if (L >= 512) return false; u.z = (int)L >> 4; u.pm = ((int)L >> 1) & 7; u.pn = (int)L & 1; return true; }
    __device__ __forceinline__ const char* pa(const Unit& u) const { return P + ((size_t)u.z * SEQ + u.pm * 256) * MEML * 2; }
    __device__ __forceinline__ const char* pb(const Unit& u) const { const int b = u.z >> 2, h = u.z & 3; return Vt + ((size_t)(h * 512 + u.pn * 256) * MROWS + b * MEML) * 2; }
};

typedef f32x4 Acc[2][2][4][2];
__device__ __forceinline__ void store_tile_bf16(const Acc& acc, bf16_t* base, size_t ldc, int wr, int wc, int fr, int fq) {
    bf16_t* p0 = base + (size_t)(wr * 64 + fr) * ldc + wc * 32 + 8 * fq;
#pragma unroll
    for (int ai = 0; ai < 2; ++ai)
#pragma unroll
        for (int m = 0; m < 4; ++m) { bf16_t* rowp = p0 + (size_t)(ai * HALF + m * 16) * ldc;
#pragma unroll
            for (int bj = 0; bj < 2; ++bj) { const f32x4 v0 = acc[ai][bj][m][0], v1 = acc[ai][bj][m][1]; u32x4 w;
                w.x = cvt_pk_bf16(v0[0], v0[1]); w.y = cvt_pk_bf16(v0[2], v0[3]); w.z = cvt_pk_bf16(v1[0], v1[1]); w.w = cvt_pk_bf16(v1[2], v1[3]);
                *(u32x4*)(rowp + bj * HALF) = w; } }
}
struct EpiP1 {
    static constexpr bool PERM = true, AFTER_DRAIN = false;
    bf16_t *QK, *VT, *KM, *VMT;
    __device__ __forceinline__ void operator()(const Acc& acc, const Unit& u, int wr, int wc, int fr, int fq) const {
        if (u.z == 0) {
            const int b = u.pm >> 3, hs0 = 4 * u.pn + (wc >> 1), hi = wc & 1;
#pragma unroll
            for (int ai = 0; ai < 2; ++ai)
#pragma unroll
                for (int m = 0; m < 4; ++m) { const int t = (u.pm & 7) * 256 + ai * HALF + wr * 64 + m * 16 + fr;
#pragma unroll
                    for (int bj = 0; bj < 2; ++bj) { const f32x4 v0 = acc[ai][bj][m][0], v1 = acc[ai][bj][m][1]; u32x4 w;
                        w.x = cvt_pk_bf16(v0[0], v0[1]); w.y = cvt_pk_bf16(v0[2], v0[3]); w.z = cvt_pk_bf16(v1[0], v1[1]); w.w = cvt_pk_bf16(v1[2], v1[3]);
                        const size_t off = ((((size_t)(b * 52 + hs0 + 2 * bj) * 64 + (t >> 5)) * 4 + fq) * 64 + hi * 32 + (t & 31)) * 8;
                        *(u32x4*)(QK + off) = w; } }
        } else if (u.z == 1) {
            const int b = u.pn >> 3, s = fq >> 1, half = fq & 1;
#pragma unroll
            for (int ai = 0; ai < 2; ++ai)
#pragma unroll
                for (int m = 0; m < 4; ++m) { const int vrow = u.pm * 256 + ai * HALF + wr * 64 + m * 16 + fr, vh = vrow >> 6, db = (vrow >> 5) & 1, dl = vrow & 31;
#pragma unroll
                    for (int bj = 0; bj < 2; ++bj) { const int blk = 8 * (u.pn & 7) + 4 * bj + wc;
                        const size_t off = ((((size_t)(b * 20 + vh) * 64 + blk) * 4 + db * 2 + s) * 64 + dl) * 8 + 4 * half;
#pragma unroll
                        for (int n = 0; n < 2; ++n) { const f32x4 v = acc[ai][bj][m][n]; u32x2 w; w.x = cvt_pk_bf16(v[0], v[1]); w.y = cvt_pk_bf16(v[2], v[3]);
                            *(u32x2*)(VT + off + n * 256) = w; } } }
        } else {
            bf16_t* base; size_t ldc;
            if (u.z == 2) { ldc = DM; base = KM + (size_t)(u.pm * 256) * ldc + u.pn * 256; }
            else { ldc = MROWS; base = VMT + (size_t)(u.pm * 256) * ldc + u.pn * 256; }
            store_tile_bf16(acc, base, ldc, wr, wc, fr, fq);
        }
    }
};
struct EpiPlain {
    static constexpr bool PERM = true, AFTER_DRAIN = false;
    bf16_t* O; int ldc;
    __device__ __forceinline__ void operator()(const Acc& acc, const Unit& u, int wr, int wc, int fr, int fq) const {
        store_tile_bf16(acc, O + (size_t)(u.pm * 256) * ldc + u.pn * 256, ldc, wr, wc, fr, fq);
    }
};
struct EpiPV {
    static constexpr bool PERM = true, AFTER_DRAIN = false;
    bf16_t* O;
    __device__ __forceinline__ void operator()(const Acc& acc, const Unit& u, int wr, int wc, int fr, int fq) const {
        const int b = u.z >> 2, h = u.z & 3;
        store_tile_bf16(acc, O + (size_t)(b * SEQ + u.pm * 256) * DM + h * 512 + u.pn * 256, DM, wr, wc, fr, fq);
    }
};
__device__ __forceinline__ void row_stats(const LAS f32x2* tab, int trow, float& mean, float& rstd) { const f32x2 s = tab[trow]; mean = s[0]; rstd = s[1]; }
struct EpiLnPlain {
    static constexpr bool PERM = true, AFTER_DRAIN = false;
    bf16_t* O; int ldc; const LAS f32x2* S; const float* cs; const float* bw;
    __device__ __forceinline__ void operator()(const Acc& acc, const Unit& u, int wr, int wc, int fr, int fq) const {
        const int colt = u.pn * 256 + wc * 32 + 8 * fq;
        bf16_t* p0 = O + (size_t)(u.pm * 256 + wr * 64 + fr) * ldc + colt;
#pragma unroll
        for (int ai = 0; ai < 2; ++ai)
#pragma unroll
            for (int m = 0; m < 4; ++m) { float mean, rstd; row_stats(S, ai * HALF + wr * 64 + m * 16 + fr, mean, rstd);
                bf16_t* rowp = p0 + (size_t)(ai * HALF + m * 16) * ldc;
#pragma unroll
                for (int bj = 0; bj < 2; ++bj) { const int col = colt + bj * HALF;
                    const f32x4 c0 = *(const f32x4*)(cs + col), c1 = *(const f32x4*)(cs + col + 4), b0 = *(const f32x4*)(bw + col), b1 = *(const f32x4*)(bw + col + 4);
                    const f32x4 v0 = (acc[ai][bj][m][0] - c0 * mean) * rstd + b0, v1 = (acc[ai][bj][m][1] - c1 * mean) * rstd + b1; u32x4 w;
                    w.x = cvt_pk_bf16(v0[0], v0[1]); w.y = cvt_pk_bf16(v0[2], v0[3]); w.z = cvt_pk_bf16(v1[0], v1[1]); w.w = cvt_pk_bf16(v1[2], v1[3]);
                    *(u32x4*)(rowp + bj * HALF) = w; } }
    }
};
template <int MODE> struct EpiRes {
    static constexpr bool PERM = false, AFTER_DRAIN = false;
    const float* X; bf16_t* Yb; const LAS f32x2* Sin; const float* g; const float* b; float* Sout;
    __device__ __forceinline__ void operator()(const Acc& acc, const Unit& u, int wr, int wc, int fr, int fq) const {
        const int col0 = u.pn * 256 + wc * 32 + 4 * fq;
#pragma unroll
        for (int ai = 0; ai < 2; ++ai)
#pragma unroll
            for (int m = 0; m < 4; ++m) { const int trow = ai * HALF + wr * 64 + m * 16 + fr, row = u.pm * 256 + trow; const size_t off = (size_t)row * DM + col0;
                float mean = 0.f, rstd = 1.f; if (MODE > 0) row_stats(Sin, trow, mean, rstd);
                f32x4 rv[2][2];
#pragma unroll
                for (int bj = 0; bj < 2; ++bj)
#pragma unroll
                    for (int n = 0; n < 2; ++n) { const int dc = bj * HALF + n * 16;
                        if (MODE == 0) rv[bj][n] = *(const f32x4*)(X + off + dc);
                        else { const u32x2 w = *(const u32x2*)(Yb + off + dc);
                            const f32x4 yv = {__builtin_bit_cast(float, w.x << 16), __builtin_bit_cast(float, w.x & 0xffff0000u), __builtin_bit_cast(float, w.y << 16), __builtin_bit_cast(float, w.y & 0xffff0000u)};
                            rv[bj][n] = (yv - mean) * rstd * *(const f32x4*)(g + col0 + dc) + *(const f32x4*)(b + col0 + dc); } }
                float ps = 0.f, pq = 0.f;
#pragma unroll
                for (int bj = 0; bj < 2; ++bj)
#pragma unroll
                    for (int n = 0; n < 2; ++n) { const f32x4 y = rv[bj][n] * ALPHA + acc[ai][bj][m][n]; u32x2 w; w.x = cvt_pk_bf16(y[0], y[1]); w.y = cvt_pk_bf16(y[2], y[3]);
                        *(u32x2*)(Yb + off + bj * HALF + n * 16) = w;
                        if (MODE < 2) { ps += (y[0] + y[1]) + (y[2] + y[3]); pq += (y[0] * y[0] + y[1] * y[1]) + (y[2] * y[2] + y[3] * y[3]); } }
                if (MODE < 2) { ps += __shfl_xor(ps, 16); ps += __shfl_xor(ps, 32); pq += __shfl_xor(pq, 16); pq += __shfl_xor(pq, 32);
                    if (fq == 0) *(f32x2*)(Sout + ((size_t)row * 32 + 4 * u.pn + wc) * 2) = (f32x2){ps, pq}; }
            }
    }
};
struct EpiSwiglu {
    static constexpr bool PERM = true, AFTER_DRAIN = false;
    bf16_t* F; const LAS f32x2* S; const float* cs; const float* bw;
    __device__ __forceinline__ void operator()(const Acc& acc, const Unit& u, int wr, int wc, int fr, int fq) const {
        bf16_t* p0 = F + (size_t)(u.pm * 256 + wr * 64 + fr) * D_FF + u.pn * 128 + wc * 32 + 8 * fq;
        const int colt = u.pn * 256 + wc * 32 + 8 * fq;
        f32x4 cg[2], cu[2], bg[2], bu[2];
#pragma unroll
        for (int n = 0; n < 2; ++n) { cg[n] = *(const f32x4*)(cs + colt + 4 * n); cu[n] = *(const f32x4*)(cs + colt + HALF + 4 * n); bg[n] = *(const f32x4*)(bw + colt + 4 * n); bu[n] = *(const f32x4*)(bw + colt + HALF + 4 * n); }
#pragma unroll
        for (int ai = 0; ai < 2; ++ai)
#pragma unroll
            for (int m = 0; m < 4; ++m) { float mean, rstd; row_stats(S, ai * HALF + wr * 64 + m * 16 + fr, mean, rstd); float o[8];
#pragma unroll
                for (int n = 0; n < 2; ++n) { const f32x4 gv = (acc[ai][0][m][n] - cg[n] * mean) * rstd + bg[n], uv = (acc[ai][1][m][n] - cu[n] * mean) * rstd + bu[n];
#pragma unroll
                    for (int j = 0; j < 4; ++j) o[n * 4 + j] = gv[j] * __builtin_amdgcn_rcpf(1.0f + fexp2(-gv[j] * LOG2E)) * uv[j]; }
                u32x4 w; w.x = cvt_pk_bf16(o[0], o[1]); w.y = cvt_pk_bf16(o[2], o[3]); w.z = cvt_pk_bf16(o[4], o[5]); w.w = cvt_pk_bf16(o[6], o[7]);
                *(u32x4*)(p0 + (size_t)(ai * HALF + m * 16) * D_FF) = w; }
    }
};
struct EpiSoftmax {
    static constexpr bool PERM = true, AFTER_DRAIN = true;
    bf16_t* P;
    __device__ __forceinline__ void fused(Acc& acc, const Unit& u, int wr, int wc, int fr, int fq, LAS unsigned char* lds, int wid, int lane) const {
        const float c = 0.04419417382415922f * LOG2E;
        LAS f32x2* T = (LAS f32x2*)lds;
        float mw[2][4];
#pragma unroll
        for (int ai = 0; ai < 2; ++ai)
#pragma unroll
            for (int m = 0; m < 4; ++m) {
                float mx = -INFINITY;
#pragma unroll
                for (int bj = 0; bj < 2; ++bj)
#pragma unroll
                    for (int n = 0; n < 2; ++n) { const f32x4 x = acc[ai][bj][m][n]; mx = fmaxf(mx, fmaxf(fmaxf(x[0], x[1]), fmaxf(x[2], x[3]))); }
                mx = fmaxf(mx, __shfl_xor(mx, 16)); mx = fmaxf(mx, __shfl_xor(mx, 32));
                float s = 0.f;
#pragma unroll
                for (int bj = 0; bj < 2; ++bj)
#pragma unroll
                    for (int n = 0; n < 2; ++n) { f32x4 x = acc[ai][bj][m][n];
#pragma unroll
                        for (int j = 0; j < 4; ++j) { x[j] = fexp2((x[j] - mx) * c); s += x[j]; }
                        acc[ai][bj][m][n] = x; }
                s += __shfl_xor(s, 16); s += __shfl_xor(s, 32);
                mw[ai][m] = mx;
                if (fq == 0) T[(ai * HALF + wr * 64 + m * 16 + fr) * 4 + wc] = (f32x2){mx, s};
            }
        LDS_WAIT(); __builtin_amdgcn_s_barrier(); asm volatile("" ::: "memory");
        bf16_t* p0 = P + ((size_t)u.z * SEQ + u.pm * 256 + wr * 64 + fr) * MEML + wc * 32 + 8 * fq;
#pragma unroll
        for (int ai = 0; ai < 2; ++ai)
#pragma unroll
            for (int m = 0; m < 4; ++m) { const int row = ai * HALF + wr * 64 + m * 16 + fr;
                const f32x2 t0 = T[row * 4 + 0], t1 = T[row * 4 + 1], t2 = T[row * 4 + 2], t3 = T[row * 4 + 3];
                const float M = fmaxf(fmaxf(t0.x, t1.x), fmaxf(t2.x, t3.x));
                const float tot = t0.y * fexp2((t0.x - M) * c) + t1.y * fexp2((t1.x - M) * c) + t2.y * fexp2((t2.x - M) * c) + t3.y * fexp2((t3.x - M) * c);
                const float f = fexp2((mw[ai][m] - M) * c) / tot;
                bf16_t* rowp = p0 + (size_t)(ai * HALF + m * 16) * MEML;
#pragma unroll
                for (int bj = 0; bj < 2; ++bj) { const f32x4 v0 = acc[ai][bj][m][0] * f, v1 = acc[ai][bj][m][1] * f; u32x4 w;
                    w.x = cvt_pk_bf16(v0[0], v0[1]); w.y = cvt_pk_bf16(v0[2], v0[3]); w.z = cvt_pk_bf16(v1[0], v1[1]); w.w = cvt_pk_bf16(v1[2], v1[3]);
                    *(u32x4*)(rowp + bj * HALF) = w; } }
    }
};

template <class Epi, class Sched, bool ALIGN_EPI>
__device__ __forceinline__ void gemm_phase(LAS unsigned char* lds, const int lda, const int ldb, const int K, const Sched& S, const Epi& E) {
    const int tid = threadIdx.x, wid = __builtin_amdgcn_readfirstlane(tid >> 6), lane = tid & 63, wr = wid >> 2, wc = wid & 3, fr = lane & 15, fq = lane >> 4;
    const int nt = K / BK;
    unsigned voffA[2], voffB[2];
#pragma unroll
    for (int i = 0; i < 2; ++i) { int R, C; stage_rc(tid * 16 + i * 8192, R, C); const int Rb = Epi::PERM ? ((R & ~31) + perm32(R & 31)) : R;
        voffA[i] = (unsigned)(R * lda + C) * 2u; voffB[i] = (unsigned)(Rb * ldb + C) * 2u; }
    const size_t kstep = (size_t)(BK * 2);
    const size_t hsA = (size_t)HALF * lda * 2, hsB = (size_t)HALF * ldb * 2;
    const unsigned ldsw = (unsigned)wid * 1024u;
    const int aoff = lds_byte(wr * 64 + fr, fq * 8), boff = lds_byte(wc * 32 + fr, fq * 8);
#define PG8_SA(b, h) (((b) * 2 + (h)) * HTB)
#define PG8_SB(b, h) ((4 + (b) * 2 + (h)) * HTB)
#define PG8_STAGE(bufoff, gbase, voff) do { _Pragma("unroll") for (int _i = 0; _i < 2; ++_i) \
        __builtin_amdgcn_global_load_lds((const unsigned*)((const char*)(gbase) + (voff)[_i]), (LAS unsigned*)(lds + (bufoff) + ldsw + _i * 8192), 16, 0, 0); } while (0)
#define PG8_LDA(dst, b, h) do { _Pragma("unroll") for (int m = 0; m < 4; ++m) _Pragma("unroll") for (int k = 0; k < 2; ++k) dst[m][k] = *(const LAS bf16x8*)(lds + PG8_SA(b, h) + aoff + m * 2048 + k * 1024); } while (0)
#define PG8_LDB(dst, b, h) do { _Pragma("unroll") for (int n = 0; n < 2; ++n) _Pragma("unroll") for (int k = 0; k < 2; ++k) dst[n][k] = *(const LAS bf16x8*)(lds + PG8_SB(b, h) + boff + n * 2048 + k * 1024); } while (0)
#define PG8_MMA(ai, bj, At, Bt) do { __builtin_amdgcn_s_setprio(1); _Pragma("unroll") for (int m = 0; m < 4; ++m) _Pragma("unroll") for (int n = 0; n < 2; ++n) _Pragma("unroll") for (int k = 0; k < 2; ++k) \
        acc[ai][bj][m][n] = __builtin_amdgcn_mfma_f32_16x16x32_bf16(Bt[n][k], At[m][k], acc[ai][bj][m][n], 0, 0, 0); __builtin_amdgcn_s_setprio(0); } while (0)
#define PG8_WAIT_V(n) asm volatile("s_waitcnt vmcnt(" #n ")" ::: "memory")
#define PG8_WAIT_L(n) asm volatile("s_waitcnt lgkmcnt(" #n ")" ::: "memory")
#define PG8_BAR __builtin_amdgcn_s_barrier()
#define PG8_SCHED __builtin_amdgcn_sched_barrier(0)
    Unit cur, nxt; int ui = 0;
    if (!S.next(0, cur)) return;
    Acc acc;
#pragma unroll
    for (int a = 0; a < 2; ++a)
#pragma unroll
        for (int b = 0; b < 2; ++b)
#pragma unroll
            for (int m = 0; m < 4; ++m)
#pragma unroll
                for (int n = 0; n < 2; ++n) acc[a][b][m][n] = (f32x4){0.f, 0.f, 0.f, 0.f};
    bf16x8 At[4][2], B0[2][2], B1[2][2];
    const char* cA = S.pa(cur); const char* cB = S.pb(cur);
    PG8_STAGE(PG8_SB(0, 0), cB, voffB); PG8_STAGE(PG8_SB(0, 1), cB + hsB, voffB); PG8_STAGE(PG8_SA(0, 0), cA, voffA); PG8_STAGE(PG8_SA(0, 1), cA + hsA, voffA);
    if (wr == 1) PG8_BAR;
    PG8_WAIT_V(2); PG8_BAR;
    PG8_STAGE(PG8_SB(1, 0), cB + kstep, voffB); PG8_STAGE(PG8_SA(1, 0), cA + kstep, voffA); PG8_STAGE(PG8_SB(1, 1), cB + hsB + kstep, voffB);
    PG8_WAIT_V(6); PG8_BAR;
    for (;;) {
        const bool has_next = S.next(ui + 1, nxt);
        const char* nA = has_next ? S.pa(nxt) : cA; const char* nB = has_next ? S.pb(nxt) : cB;
#pragma unroll 1
        for (int t = 0; t < nt; t += 2) {
            const bool last = (t == nt - 2);
            const char* a1 = cA + (size_t)(t + 1) * kstep;
            const char* a2 = last ? nA : cA + (size_t)(t + 2) * kstep; const char* b2 = last ? nB : cB + (size_t)(t + 2) * kstep;
            const char* a3 = a2 + kstep; const char* b3 = b2 + kstep;
            PG8_LDB(B0, 0, 0); PG8_LDB(B1, 0, 1); PG8_SCHED; PG8_LDA(At, 0, 0); PG8_STAGE(PG8_SA(1, 1), a1 + hsA, voffA);
            PG8_WAIT_V(8); PG8_WAIT_L(0); PG8_BAR; PG8_MMA(0, 0, At, B0); PG8_MMA(0, 1, At, B1); PG8_BAR; PG8_SCHED;
            PG8_LDA(At, 0, 1); PG8_STAGE(PG8_SB(0, 0), b2, voffB); PG8_STAGE(PG8_SB(0, 1), b2 + hsB, voffB); PG8_STAGE(PG8_SA(0, 0), a2, voffA);
            PG8_WAIT_V(8); PG8_WAIT_L(0); PG8_BAR; PG8_MMA(1, 0, At, B0); PG8_MMA(1, 1, At, B1); PG8_BAR; PG8_SCHED;
            PG8_LDB(B0, 1, 0); PG8_LDB(B1, 1, 1); PG8_SCHED; PG8_LDA(At, 1, 0); PG8_STAGE(PG8_SA(0, 1), a2 + hsA, voffA);
            PG8_WAIT_V(8); PG8_WAIT_L(0); PG8_BAR; PG8_MMA(0, 0, At, B0); PG8_MMA(0, 1, At, B1); PG8_BAR; PG8_SCHED;
            PG8_LDA(At, 1, 1); PG8_STAGE(PG8_SB(1, 0), b3, voffB); PG8_STAGE(PG8_SB(1, 1), b3 + hsB, voffB); PG8_STAGE(PG8_SA(1, 0), a3, voffA);
            PG8_WAIT_V(8); PG8_WAIT_L(0); PG8_BAR; PG8_MMA(1, 0, At, B0); PG8_MMA(1, 1, At, B1); PG8_BAR; PG8_SCHED;
        }
        if constexpr (ALIGN_EPI) { if (wr == 0) PG8_BAR; }
        if constexpr (!Epi::AFTER_DRAIN) { E(acc, cur, wr, wc, fr, fq); }
        if (!has_next) break;
#pragma unroll
        for (int a = 0; a < 2; ++a)
#pragma unroll
            for (int b = 0; b < 2; ++b)
#pragma unroll
                for (int m = 0; m < 4; ++m)
#pragma unroll
                    for (int n = 0; n < 2; ++n) acc[a][b][m][n] = (f32x4){0.f, 0.f, 0.f, 0.f};
        cur = nxt; cA = nA; cB = nB; ++ui;
        if constexpr (ALIGN_EPI) { if (wr == 1) PG8_BAR; }
    }
    PG8_WAIT_V(0);
    if constexpr (!ALIGN_EPI) { if (wr == 0) PG8_BAR; }
    PG8_BAR;
    if constexpr (Epi::AFTER_DRAIN) { E.fused(acc, cur, wr, wc, fr, fq, lds, wid, lane); }
#undef PG8_SA
#undef PG8_SB
#undef PG8_STAGE
#undef PG8_LDA
#undef PG8_LDB
#undef PG8_MMA
#undef PG8_WAIT_V
#undef PG8_WAIT_L
#undef PG8_BAR
#undef PG8_SCHED
}
}

__device__ __forceinline__ void transpose_item(const float* W, int N, bf16_t* WT, int ldt, int k0, int n0, int dest_row0, LAS float* scr, int lane) {
#pragma unroll 8
    for (int i = 0; i < 32; ++i) { const int kk = 2 * i + (lane >> 5); scr[kk * 33 + (lane & 31)] = W[(size_t)(k0 + kk) * N + n0 + (lane & 31)]; }
    LDS_WAIT(); asm volatile("" ::: "memory");
    const int c = lane & 7;
#pragma unroll
    for (int j = 0; j < 4; ++j) { const int n = (lane >> 3) + 8 * j; const LAS float* s = scr + (8 * c) * 33 + n;
        u32x4 o; o.x = cvt_pk_bf16(s[0 * 33], s[1 * 33]); o.y = cvt_pk_bf16(s[2 * 33], s[3 * 33]); o.z = cvt_pk_bf16(s[4 * 33], s[5 * 33]); o.w = cvt_pk_bf16(s[6 * 33], s[7 * 33]);
        *(u32x4*)(WT + (size_t)(dest_row0 + n) * ldt + k0 + 8 * c) = o; }
    LDS_WAIT(); asm volatile("" ::: "memory");
}

__device__ __forceinline__ void transpose_item_ln(const float* W, int N, bf16_t* WT, int ldt, int k0, int n0, int dest_row0, LAS float* scr, int lane, const float* g, const float* b, float* csp_out, float* bwp_out) {
    float csp = 0.f, bwp = 0.f;
#pragma unroll 8
    for (int i = 0; i < 32; ++i) { const int kk = 2 * i + (lane >> 5); const float w = W[(size_t)(k0 + kk) * N + n0 + (lane & 31)], wg = w * g[k0 + kk];
        scr[kk * 33 + (lane & 31)] = wg; csp += wg; bwp += w * b[k0 + kk]; }
    csp += __shfl_xor(csp, 32); bwp += __shfl_xor(bwp, 32);
    if (lane < 32) { csp_out[lane] = csp; bwp_out[lane] = bwp; }
    LDS_WAIT(); asm volatile("" ::: "memory");
    const int c = lane & 7;
#pragma unroll
    for (int j = 0; j < 4; ++j) { const int n = (lane >> 3) + 8 * j; const LAS float* s = scr + (8 * c) * 33 + n;
        u32x4 o; o.x = cvt_pk_bf16(s[0 * 33], s[1 * 33]); o.y = cvt_pk_bf16(s[2 * 33], s[3 * 33]); o.z = cvt_pk_bf16(s[4 * 33], s[5 * 33]); o.w = cvt_pk_bf16(s[6 * 33], s[7 * 33]);
        *(u32x4*)(WT + (size_t)(dest_row0 + n) * ldt + k0 + 8 * c) = o; }
    LDS_WAIT(); asm volatile("" ::: "memory");
}

__device__ __forceinline__ int crow(int r, int hi) { return (r & 3) + 8 * (r >> 2) + 4 * hi; }

__device__ __forceinline__ void load_k(bf16x8 (&kf)[4], const bf16_t* blk) {
#pragma unroll
    for (int s = 0; s < 4; ++s) kf[s] = *(const bf16x8*)(blk + 512 * s);
}
__device__ __forceinline__ void load_v(bf16x8 (&vf)[2][2], const bf16_t* blk) {
#pragma unroll
    for (int db = 0; db < 2; ++db)
#pragma unroll
        for (int s = 0; s < 2; ++s) vf[db][s] = *(const bf16x8*)(blk + 512 * (db * 2 + s));
}
__device__ __forceinline__ bf16x8 pack8(const float* p) {
    const unsigned a = cvt_pk_bf16(p[0], p[1]), b = cvt_pk_bf16(p[2], p[3]), c = cvt_pk_bf16(p[4], p[5]), d = cvt_pk_bf16(p[6], p[7]);
    u32x4 w = {a, b, c, d}; return __builtin_bit_cast(bf16x8, w);
}
__device__ __forceinline__ void rms_store(const f32x16& o0, const f32x16& o1, const float* g, bf16_t* Orow, int hi) {
    float ss = 0.f;
#pragma unroll
    for (int r = 0; r < 16; ++r) ss += o0[r] * o0[r] + o1[r] * o1[r];
    ss += __shfl_xor(ss, 32);
    const float rs = 1.0f / sqrtf(ss * (1.0f / 64.0f) + RMS_EPS);
#pragma unroll
    for (int db = 0; db < 2; ++db)
#pragma unroll
        for (int i = 0; i < 4; ++i) { const int d = 32 * db + 8 * i + 4 * hi; const f32x4 gg = *(const f32x4*)(g + d);
            const float a0 = (db ? o1[4 * i + 0] : o0[4 * i + 0]) * rs * gg[0], a1 = (db ? o1[4 * i + 1] : o0[4 * i + 1]) * rs * gg[1];
            const float a2 = (db ? o1[4 * i + 2] : o0[4 * i + 2]) * rs * gg[2], a3 = (db ? o1[4 * i + 3] : o0[4 * i + 3]) * rs * gg[3];
            u32x2 w; w.x = cvt_pk_bf16(a0, a1); w.y = cvt_pk_bf16(a2, a3); *(u32x2*)(Orow + d) = w; }
}

template <bool DIAG>
__device__ __forceinline__ void sb_block(const f32x16& st, float& R, int lim  , int hi, bf16x8& pb0, bf16x8& pb1) {
    float L[16], lb[16];
#pragma unroll
    for (int r = 0; r < 16; ++r) {
        const float z2 = st[r] * (0.125f * LOG2E);
        const float e = fexp2(-fabsf(z2));
        const float l2 = flog2(1.0f + e);
        float b = fminf(z2, 0.f) - l2;
        float l1 = b - z2;
        if (DIAG) { const bool valid = crow(r, hi) < lim; l1 = valid ? l1 : 0.f; b = valid ? b : -INFINITY; }
        L[r] = l1; lb[r] = b;
    }
    float gs[4], pg[4];
#pragma unroll
    for (int i = 0; i < 4; ++i) { gs[i] = (L[4 * i] + L[4 * i + 1]) + (L[4 * i + 2] + L[4 * i + 3]); pg[i] = __shfl_xor(gs[i], 32); }
    float p[16];
    float suf = R;
#pragma unroll
    for (int i = 3; i >= 0; --i) {
        float off = suf + (hi == 0 ? pg[i] : 0.f);
        p[4 * i + 3] = fexp2(lb[4 * i + 3] + off); off += L[4 * i + 3];
        p[4 * i + 2] = fexp2(lb[4 * i + 2] + off); off += L[4 * i + 2];
        p[4 * i + 1] = fexp2(lb[4 * i + 1] + off); off += L[4 * i + 1];
        p[4 * i + 0] = fexp2(lb[4 * i + 0] + off);
        suf += gs[i] + pg[i];
    }
    R = suf;
    pb0 = pack8(p); pb1 = pack8(p + 8);
}

__device__ __forceinline__ void sb_wave(const bf16_t* QK, const bf16_t* VT, bf16_t* O, const float* g_sb, int b, int h, int t0, int lane) {
    const int q = lane & 31, hi = lane >> 5;
    const size_t rowq = (size_t)(b * SEQ + t0 + q);
    const bf16_t* qblk = QK + ((size_t)(b * 52 + 20 + h) * 64) * 2048 + lane * 8;
    const bf16_t* kblk = QK + ((size_t)(b * 52 + 36 + h) * 64) * 2048 + lane * 8;
    const bf16_t* vblk = VT + ((size_t)(b * 20 + 4 + h) * 64) * 2048 + lane * 8;
    bf16x8 qf[4]; load_k(qf, qblk + (size_t)(t0 >> 5) * 2048);
    f32x16 o0, o1;
#pragma unroll
    for (int r = 0; r < 16; ++r) { o0[r] = 0.f; o1[r] = 0.f; }
    float R = 0.f;
    bf16x8 kf[4], kn[4], vf[2][2], pb0, pb1;
    load_k(kf, kblk + (size_t)(t0 >> 5) * 2048);
    for (int k0 = t0; k0 >= 0; k0 -= 32) {
        load_v(vf, vblk + (size_t)(k0 >> 5) * 2048);
        if (k0 >= 32) load_k(kn, kblk + (size_t)((k0 >> 5) - 1) * 2048);
        f32x16 st;
#pragma unroll
        for (int r = 0; r < 16; ++r) st[r] = 0.f;
#pragma unroll
        for (int s = 0; s < 4; ++s) st = __builtin_amdgcn_mfma_f32_32x32x16_bf16(kf[s], qf[s], st, 0, 0, 0);
        if (k0 == t0) sb_block<true>(st, R, q, hi, pb0, pb1); else sb_block<false>(st, R, 64, hi, pb0, pb1);
        o0 = __builtin_amdgcn_mfma_f32_32x32x16_bf16(vf[0][0], pb0, o0, 0, 0, 0);
        o0 = __builtin_amdgcn_mfma_f32_32x32x16_bf16(vf[0][1], pb1, o0, 0, 0, 0);
        o1 = __builtin_amdgcn_mfma_f32_32x32x16_bf16(vf[1][0], pb0, o1, 0, 0, 0);
        o1 = __builtin_amdgcn_mfma_f32_32x32x16_bf16(vf[1][1], pb1, o1, 0, 0, 0);
        if (__all(R < -150.0f)) break;
#pragma unroll
        for (int s = 0; s < 4; ++s) kf[s] = kn[s];
    }
    rms_store(o0, o1, g_sb + h * 64, O + rowq * DM + 1024 + h * 64, hi);
}

__device__ __forceinline__ void swa_wave(const bf16_t* QK, const bf16_t* VT, bf16_t* O, const float* g_swa, const float* sinks, int b, int hq, int t0, int lane) {
    const int q = lane & 31, hi = lane >> 5, kvh = hq >> 2;
    const size_t rowq = (size_t)(b * SEQ + t0 + q);
    const bf16_t* qblk = QK + ((size_t)(b * 52 + hq) * 64) * 2048 + lane * 8;
    const bf16_t* kblk = QK + ((size_t)(b * 52 + 16 + kvh) * 64) * 2048 + lane * 8;
    const bf16_t* vblk = VT + ((size_t)(b * 20 + kvh) * 64) * 2048 + lane * 8;
    bf16x8 qf[4]; load_k(qf, qblk + (size_t)(t0 >> 5) * 2048);
    const float slope2 = fexp2(-0.5f * (float)(hq + 1)) * LOG2E;
    const float sink2 = sinks[hq] * LOG2E;
    f32x16 st[5];
#pragma unroll
    for (int jb = 0; jb < 5; ++jb) {
        const int k0 = t0 - 128 + 32 * jb;
#pragma unroll
        for (int r = 0; r < 16; ++r) st[jb][r] = 0.f;
        if (k0 >= 0) { bf16x8 kf[4]; load_k(kf, kblk + (size_t)(k0 >> 5) * 2048);
#pragma unroll
            for (int s = 0; s < 4; ++s) st[jb] = __builtin_amdgcn_mfma_f32_32x32x16_bf16(kf[s], qf[s], st[jb], 0, 0, 0); }
    }
    float mx = sink2;
#pragma unroll
    for (int jb = 0; jb < 5; ++jb) {
        const int k0 = t0 - 128 + 32 * jb;
#pragma unroll
        for (int r = 0; r < 16; ++r) { const int dist = q + 128 - 32 * jb - crow(r, hi);
            const bool valid = (k0 >= 0) && (dist >= 0) && (dist < 128);
            const float sc = valid ? (st[jb][r] * (0.125f * LOG2E) - slope2 * (float)dist) : -INFINITY;
            st[jb][r] = sc; mx = fmaxf(mx, sc); }
    }
    mx = fmaxf(mx, __shfl_xor(mx, 32));
    float sum = 0.f;
#pragma unroll
    for (int jb = 0; jb < 5; ++jb)
#pragma unroll
        for (int r = 0; r < 16; ++r) { const float p = fexp2(st[jb][r] - mx); st[jb][r] = p; sum += p; }
    sum += __shfl_xor(sum, 32);
    const float inv = 1.0f / (sum + fexp2(sink2 - mx));
    f32x16 o0, o1;
#pragma unroll
    for (int r = 0; r < 16; ++r) { o0[r] = 0.f; o1[r] = 0.f; }
#pragma unroll
    for (int jb = 0; jb < 5; ++jb) {
        const int k0 = t0 - 128 + 32 * jb;
        if (k0 >= 0) { bf16x8 vf[2][2]; load_v(vf, vblk + (size_t)(k0 >> 5) * 2048);
            float p[16];
#pragma unroll
            for (int r = 0; r < 16; ++r) p[r] = st[jb][r] * inv;
            const bf16x8 pb0 = pack8(p), pb1 = pack8(p + 8);
            o0 = __builtin_amdgcn_mfma_f32_32x32x16_bf16(vf[0][0], pb0, o0, 0, 0, 0);
            o0 = __builtin_amdgcn_mfma_f32_32x32x16_bf16(vf[0][1], pb1, o0, 0, 0, 0);
            o1 = __builtin_amdgcn_mfma_f32_32x32x16_bf16(vf[1][0], pb0, o1, 0, 0, 0);
            o1 = __builtin_amdgcn_mfma_f32_32x32x16_bf16(vf[1][1], pb1, o1, 0, 0, 0); }
    }
    rms_store(o0, o1, g_swa + hq * 64, O + rowq * DM + hq * 64, hi);
}

__device__ __forceinline__ f32x4 bf4lo(const u32x4& w) { return (f32x4){__builtin_bit_cast(float, w.x << 16), __builtin_bit_cast(float, w.x & 0xffff0000u), __builtin_bit_cast(float, w.y << 16), __builtin_bit_cast(float, w.y & 0xffff0000u)}; }
__device__ __forceinline__ f32x4 bf4hi(const u32x4& w) { return (f32x4){__builtin_bit_cast(float, w.z << 16), __builtin_bit_cast(float, w.z & 0xffff0000u), __builtin_bit_cast(float, w.w << 16), __builtin_bit_cast(float, w.w & 0xffff0000u)}; }
__device__ __forceinline__ void ln_rows(const bf16_t* Y, const float* g, const float* bta, float* Hf, bf16_t* Hb, int gw, int ngw, int lane) {
    for (int row = gw; row < MTOK; row += ngw) {
        const u32x4* yr = (const u32x4*)(Y + (size_t)row * DM) + lane;
        f32x4 v[8]; float s = 0.f;
#pragma unroll
        for (int j = 0; j < 4; ++j) { const u32x4 w = yr[64 * j]; v[2 * j] = bf4lo(w); v[2 * j + 1] = bf4hi(w); }
#pragma unroll
        for (int j = 0; j < 8; ++j) s += (v[j][0] + v[j][1]) + (v[j][2] + v[j][3]);
        const float mean = wave_sum(s) * (1.0f / DM); float s2 = 0.f;
#pragma unroll
        for (int j = 0; j < 8; ++j) { v[j] = v[j] - mean; s2 += (v[j][0] * v[j][0] + v[j][1] * v[j][1]) + (v[j][2] * v[j][2] + v[j][3] * v[j][3]); }
        const float rstd = 1.0f / sqrtf(wave_sum(s2) * (1.0f / DM) + LN_EPS);
#pragma unroll
        for (int j = 0; j < 4; ++j) { const int e = 8 * (lane + 64 * j);
            const f32x4 g0 = *(const f32x4*)(g + e), g1 = *(const f32x4*)(g + e + 4), b0 = *(const f32x4*)(bta + e), b1 = *(const f32x4*)(bta + e + 4);
            const f32x4 o0 = v[2 * j] * rstd * g0 + b0, o1 = v[2 * j + 1] * rstd * g1 + b1;
            if (Hf) { *(f32x4*)(Hf + (size_t)row * DM + e) = o0; *(f32x4*)(Hf + (size_t)row * DM + e + 4) = o1; }
            if (Hb) { u32x4 w; w.x = cvt_pk_bf16(o0[0], o0[1]); w.y = cvt_pk_bf16(o0[2], o0[3]); w.z = cvt_pk_bf16(o1[0], o1[1]); w.w = cvt_pk_bf16(o1[2], o1[3]); *(u32x4*)(Hb + (size_t)row * DM + e) = w; } }
    }
}

#define XB_TMO      128
#define XB_XCNT(j)  (256  + 64 * (j))
#define XB_XSUB(j)  (1280 + 64 * (j))
#define XB_XGEN(j)  (2304 + 64 * (j))
#define XB_TOP      3328
#define XB_TOPGEN   3392
#define XCD_BAR_WORDS 3456
#define XB_SPIN_CAP (1u << 18)

__device__ __forceinline__ unsigned xb_ld(unsigned* p)              { return __hip_atomic_load(p, __ATOMIC_RELAXED, __HIP_MEMORY_SCOPE_AGENT); }
__device__ __forceinline__ unsigned xb_add(unsigned* p, unsigned v) { return __hip_atomic_fetch_add(p, v, __ATOMIC_RELAXED, __HIP_MEMORY_SCOPE_AGENT); }
__device__ __forceinline__ unsigned xb_xcc_id() { return (unsigned)__builtin_amdgcn_s_getreg((3 << 11) | 20) & 0xFu; }
#define XB_SPIN(cond, bar) do { unsigned _sp = 0; while (cond) { __builtin_amdgcn_s_sleep(1); \
    if ((++_sp & 255u) == 0u) { if (xb_ld(&(bar)[XB_TMO])) break; if (_sp > XB_SPIN_CAP) { atomicAdd(&(bar)[XB_TMO], 1u); break; } } } } while (0)

struct XcdBarrier {
    unsigned* bar; unsigned x;
    volatile LAS unsigned* st;
};

__device__ __forceinline__ XcdBarrier xcd_barrier_post(unsigned* bar, volatile LAS unsigned* st) {
    XcdBarrier b; b.bar = bar; b.x = xb_xcc_id(); b.st = st;
    if (threadIdx.x == 0) (void)xb_add(&bar[XB_XCNT(b.x)], 1u);
    return b;
}
__device__ __forceinline__ void xcd_barrier_complete(unsigned* bar, unsigned x, unsigned& nloc, unsigned& nx) {
    const unsigned G = gridDim.x * gridDim.y * gridDim.z;
    unsigned sum, cnt, mine, sp = 0u;
    for (;;) {
        sum = 0u; cnt = 0u; mine = 0u;
#pragma unroll
        for (unsigned j = 0; j < 16; ++j) { const unsigned c = xb_ld(&bar[XB_XCNT(j)]); sum += c; cnt += (c > 0u) ? 1u : 0u; mine = (j == x) ? c : mine; }
        if (sum == G) break;
        __builtin_amdgcn_s_sleep(1);
        if ((++sp & 255u) == 0u) { if (xb_ld(&bar[XB_TMO])) break; if (sp > XB_SPIN_CAP) { atomicAdd(&bar[XB_TMO], 1u); break; } }
    }
    nloc = mine > 0u ? mine : 1u; nx = cnt > 0u ? cnt : 1u;
}

__device__ __forceinline__ void xcd_barrier(const XcdBarrier& b) {
    asm volatile("s_waitcnt vmcnt(0)" ::: "memory");
    __syncthreads();
    if (threadIdx.x == 0) {
        unsigned* bar = b.bar;
        __builtin_amdgcn_s_waitcnt(0);
        unsigned nloc = b.st[0], nx = b.st[1];
        if (nloc == 0u) { xcd_barrier_complete(bar, b.x, nloc, nx); b.st[0] = nloc; b.st[1] = nx; }
        const unsigned old = xb_add(&bar[XB_XSUB(b.x)], 1u);
        const unsigned gen = old / nloc;
        if (old + 1u == (gen + 1u) * nloc) {
            __builtin_amdgcn_fence(__ATOMIC_RELEASE, "agent");
            asm volatile("s_waitcnt vmcnt(0)" ::: "memory");
            const unsigned og = xb_add(&bar[XB_TOP], 1u);
            const unsigned tg = og / nx;
            if (og + 1u == (tg + 1u) * nx) xb_add(&bar[XB_TOPGEN], 1u);
            else XB_SPIN(xb_ld(&bar[XB_TOPGEN]) == tg, bar);
            __builtin_amdgcn_fence(__ATOMIC_ACQUIRE, "agent");
            xb_add(&bar[XB_XGEN(b.x)], 1u);
            asm volatile("s_waitcnt vmcnt(0)" ::: "memory");
        } else {
            XB_SPIN(xb_ld(&bar[XB_XGEN(b.x)]) == gen, bar);
            __builtin_amdgcn_fence(__ATOMIC_ACQUIRE, "agent");
            asm volatile("s_waitcnt vmcnt(0)" ::: "memory");
        }
    }
    __syncthreads();
}


__device__ __forceinline__ void stats_table(const float* Sp, int pm, LAS f32x2* tab, int tid) {
    const int row = tid >> 1, half = tid & 1;
    const f32x4* p = (const f32x4*)(Sp + ((size_t)(pm * 256 + row) * 32 + half * 16) * 2);
    float s = 0.f, q = 0.f;
#pragma unroll
    for (int j = 0; j < 8; ++j) { const f32x4 v = p[j]; s += v[0] + v[2]; q += v[1] + v[3]; }
    s += __shfl_xor(s, 1); q += __shfl_xor(q, 1);
    const float mean = s * (1.0f / DM), var = q * (1.0f / DM) - mean * mean;
    if (half == 0) tab[row] = (f32x2){mean, 1.0f / sqrtf(var + LN_EPS)};
    __syncthreads();
}

struct Args { const float* in[18]; float* out; unsigned char* ws; int ph_lo, ph_hi; };
constexpr int LDS_BYTES = 147456;

__global__ void __launch_bounds__(512, 2) hymba_fwd(Args a) {
    extern __shared__ __attribute__((aligned(16))) unsigned char lds_raw[];
    LAS unsigned char* lds = (LAS unsigned char*)lds_raw;
    cg::grid_group grid = cg::this_grid();
    const int tid = threadIdx.x, lane = tid & 63, wave = __builtin_amdgcn_readfirstlane(tid >> 6);
    const int G = gridDim.x, c = blockIdx.x;
    const int gw = c * 8 + wave, ngw = G * 8;
    unsigned char* ws = a.ws;
    const float *x = a.in[0], *mem = a.in[1], *w_in = a.in[2], *sinks = a.in[3], *g_swa = a.in[4], *g_sb = a.in[5], *w_o = a.in[6], *ln1_g = a.in[7], *ln1_b = a.in[8],
                *w_q_mem = a.in[9], *w_kv_mem = a.in[10], *w_o_mem = a.in[11], *ln2_g = a.in[12], *ln2_b = a.in[13], *w_gate_up = a.in[14], *w_down = a.in[15], *ln3_g = a.in[16], *ln3_b = a.in[17];
    bf16_t* ALL = (bf16_t*)(ws + WS_ALL);
    bf16_t* Ob = ALL;
    bf16_t* Hb = ALL;
    bf16_t *QK = (bf16_t*)(ws + WS_QK), *VT = (bf16_t*)(ws + WS_VT), *KM = (bf16_t*)(ws + WS_KM), *VMT = (bf16_t*)(ws + WS_VMT);
    bf16_t *WoT = (bf16_t*)(ws + WS_WO), *WqmT = (bf16_t*)(ws + WS_WQM), *WomT = (bf16_t*)(ws + WS_WOM), *WguT = (bf16_t*)(ws + WS_WGU), *WdT = (bf16_t*)(ws + WS_WD);
    bf16_t *Qm = (bf16_t*)(ws + WS_QM), *Pm = (bf16_t*)(ws + WS_P), *Oc = (bf16_t*)(ws + WS_OC), *Fb = (bf16_t*)(ws + WS_F);
    bf16_t* Yb = (bf16_t*)(ws + WS_Y);
    float *SP1 = (float*)(ws + WS_SP1), *SP2 = (float*)(ws + WS_SP2);
    float *csp = (float*)(ws + WS_CSP), *csf = (float*)(ws + WS_CSF);
    const float *cs1 = csf, *bw1 = csf + NCS, *cs2 = csf + 2048, *bw2 = csf + NCS + 2048;
    LAS f32x2* tab = (LAS f32x2*)(lds + 131072 + 1024);
    float* Hf = a.out;
    const int lo = a.ph_lo, hi_ = a.ph_hi;
    volatile LAS unsigned* xst = (volatile LAS unsigned*)(lds + 131072);
    if (tid == 0) { xst[0] = 0u; xst[1] = 0u; }
    __syncthreads();
    XcdBarrier xbar; xbar.bar = (unsigned*)(ws + WS_CTL); xbar.x = 0; xbar.st = xst;
    if (hi_ - lo > 1) { xbar = xcd_barrier_post((unsigned*)(ws + WS_CTL), xst);
        grid.sync(); }
#ifdef ONLY
#define IN(k) ((k) == ONLY && lo <= (k) && (k) < hi_)
#else
#define IN(k) (lo <= (k) && (k) < hi_)
#endif
#define SEAM(k) do { if (IN(k) && IN((k) + 1)) { xcd_barrier(xbar); } } while (0)
#ifndef REPEAT
#define REPEAT (-1)
#endif
#define REP(k) for (int rep_ = 0; rep_ < ((k) == REPEAT ? 2 : 1); ++rep_, ((k) == REPEAT ? grid.sync() : (void)0))

    if (IN(0)) REP(0) {
        LAS float* scr = (LAS float*)(lds + wave * 16384);
        constexpr int I0 = 32 * 144, I1 = 32 * 128, I2 = 32 * 64, I5 = 32 * 352, I6 = 88 * 64;
        constexpr int NIT = I0 + I1 + 3 * I2 + I5 + I6;
        for (int it = gw; it < NIT; it += ngw) {
            int r = it;
            if (r < I0) { const int kb = r / 144, nb = r % 144; transpose_item(w_in, D_IN, ALL, DM, 64 * kb, 32 * nb, 18432 + 32 * nb, scr, lane); continue; } r -= I0;
            if (r < I1) { const int kb = r / 128, nb = r % 128; transpose_item(w_kv_mem, 4096, ALL, DM, 64 * kb, 32 * nb, 23040 + 32 * nb, scr, lane); continue; } r -= I1;
            if (r < I2) { const int kb = r / 64, nb = r % 64; transpose_item(w_o, DM, WoT, DM, 64 * kb, 32 * nb, 32 * nb, scr, lane); continue; } r -= I2;
            if (r < I2) { const int kb = r / 64, nb = r % 64; transpose_item_ln(w_q_mem, DM, WqmT, DM, 64 * kb, 32 * nb, 32 * nb, scr, lane, ln1_g, ln1_b, csp + (size_t)(kb * 2) * NCS + 32 * nb, csp + (size_t)(kb * 2 + 1) * NCS + 32 * nb); continue; } r -= I2;
            if (r < I2) { const int kb = r / 64, nb = r % 64; transpose_item(w_o_mem, DM, WomT, DM, 64 * kb, 32 * nb, 32 * nb, scr, lane); continue; } r -= I2;
            if (r < I5) { const int kb = r / 352, nb = r % 352; const int n0 = 32 * nb, part = n0 >= D_FF ? 1 : 0, j = n0 - part * D_FF;
                const int dr = 256 * (j >> 7) + 128 * part + (j & 127); transpose_item_ln(w_gate_up, 2 * D_FF, WguT, DM, 64 * kb, n0, dr, scr, lane, ln2_g, ln2_b, csp + (size_t)(kb * 2) * NCS + 2048 + dr, csp + (size_t)(kb * 2 + 1) * NCS + 2048 + dr); continue; } r -= I5;
            { const int kb = r / 64, nb = r % 64; transpose_item(w_down, DM, WdT, D_FF, 64 * kb, 32 * nb, 32 * nb, scr, lane); }
        }
        const size_t nx8 = (size_t)MTOK * DM / 8, nm8 = (size_t)MROWS * DM / 8;
        for (size_t i = (size_t)c * 512 + tid; i < nx8 + nm8; i += (size_t)G * 512) {
            const float* src = i < nx8 ? x + i * 8 : mem + (i - nx8) * 8;
            const f32x4 v0 = *(const f32x4*)src, v1 = *(const f32x4*)(src + 4);
            u32x4 w; w.x = cvt_pk_bf16(v0[0], v0[1]); w.y = cvt_pk_bf16(v0[2], v0[3]); w.z = cvt_pk_bf16(v1[0], v1[1]); w.w = cvt_pk_bf16(v1[2], v1[3]);
            *(u32x4*)(ALL + i * 8) = w;
        }
    }
    SEAM(0);
    if (IN(1)) REP(1) {
        pg8::SchedP1 S{(const char*)ALL, G, c};
        pg8::EpiP1 E{QK, VT, KM, VMT};
        pg8::gemm_phase<pg8::EpiP1, pg8::SchedP1, true>(lds, DM, DM, DM, S, E);
    }
    SEAM(1);
    if (IN(2)) REP(2) {
        if (G == 256) {
            const int pair = c >> 1, b = pair >> 4, h = pair & 15;
#pragma unroll 1
            for (int j = 0; j < 4; ++j) {
                const int qb = (c & 1) ? (j == 0 ? 1 : (j == 1 ? 6 : (j == 2 ? 3 : 4))) : (j == 0 ? 0 : (j == 1 ? 7 : (j == 2 ? 2 : 5)));
                const int w = (j & 1) ? 7 - wave : wave;
                sb_wave(QK, VT, Ob, g_sb, b, h, 256 * qb + 32 * w, lane);
            }
        } else {
            for (int u = gw; u < NB * 16 * 64; u += ngw) sb_wave(QK, VT, Ob, g_sb, u >> 10, (u >> 6) & 15, 32 * (u & 63), lane);
        }
        for (int u = gw; u < NB * 16 * 64; u += ngw) swa_wave(QK, VT, Ob, g_swa, sinks, u >> 10, (u >> 6) & 15, 32 * (u & 63), lane);
    }
    SEAM(2);
    if (IN(3)) {
        for (int i = c * 512 + tid; i < 2 * NCS; i += G * 512) { float acc_ = 0.f;
#pragma unroll 8
            for (int kb = 0; kb < 32; ++kb) acc_ += csp[(size_t)kb * 2 * NCS + i];
            csf[i] = acc_; }
    }
    if (IN(3)) {
        pg8::SchedPlain S; S.init(Ob, DM, WoT, DM, MTOK, DM, G, c);
        pg8::EpiRes<0> E{x, Yb, nullptr, nullptr, nullptr, SP1};
        pg8::gemm_phase<pg8::EpiRes<0>, pg8::SchedPlain, true>(lds, DM, DM, DM, S, E);
    }
    SEAM(3);
    if (IN(5)) {
        pg8::SchedPlain S; S.init(Yb, DM, WqmT, DM, MTOK, DM, G, c);
        { pg8::Unit u0; int pm0 = 0; if (S.next(0, u0)) pm0 = u0.pm; stats_table(SP1, pm0, tab, tid); }
        pg8::EpiLnPlain E{Qm, DM, tab, cs1, bw1};
        pg8::gemm_phase<pg8::EpiLnPlain, pg8::SchedPlain, true>(lds, DM, DM, DM, S, E);
    }
    SEAM(5);
    if (IN(6)) {
        pg8::SchedQK S{(const char*)Qm, (const char*)KM, G, c};
        pg8::EpiSoftmax E{Pm};
        pg8::gemm_phase<pg8::EpiSoftmax, pg8::SchedQK, false>(lds, DM, DM, 512, S, E);
    }
    SEAM(6);
    if (IN(7)) {
        pg8::SchedPV S{(const char*)Pm, (const char*)VMT, G, c};
        pg8::EpiPV E{Oc};
        pg8::gemm_phase<pg8::EpiPV, pg8::SchedPV, true>(lds, MEML, MROWS, MEML, S, E);
    }
    SEAM(7);
    if (IN(8)) {
        pg8::SchedPlain S; S.init(Oc, DM, WomT, DM, MTOK, DM, G, c);
        { pg8::Unit u0; int pm0 = 0; if (S.next(0, u0)) pm0 = u0.pm; stats_table(SP1, pm0, tab, tid); }
        pg8::EpiRes<1> E{nullptr, Yb, tab, ln1_g, ln1_b, SP2};
        pg8::gemm_phase<pg8::EpiRes<1>, pg8::SchedPlain, true>(lds, DM, DM, DM, S, E);
    }
    SEAM(8);
    if (IN(10)) {
        pg8::SchedPlain S; S.init(Yb, DM, WguT, DM, MTOK, 2 * D_FF, G, c);
        { pg8::Unit u0; int pm0 = 0; if (S.next(0, u0)) pm0 = u0.pm; stats_table(SP2, pm0, tab, tid); }
        pg8::EpiSwiglu E{Fb, tab, cs2, bw2};
        pg8::gemm_phase<pg8::EpiSwiglu, pg8::SchedPlain, true>(lds, DM, DM, DM, S, E);
    }
    SEAM(10);
    if (IN(11)) {
        pg8::SchedPlain S; S.init(Fb, D_FF, WdT, D_FF, MTOK, DM, G, c);
        { pg8::Unit u0; int pm0 = 0; if (S.next(0, u0)) pm0 = u0.pm; stats_table(SP2, pm0, tab, tid); }
        pg8::EpiRes<2> E{nullptr, Yb, tab, ln2_g, ln2_b, nullptr};
        pg8::gemm_phase<pg8::EpiRes<2>, pg8::SchedPlain, true>(lds, D_FF, D_FF, D_FF, S, E);
    }
    SEAM(11);
    if (IN(12)) ln_rows(Yb, ln3_g, ln3_b, a.out, nullptr, gw, ngw, lane);
#undef IN
#undef SEAM
}

extern "C" void kernel_launch(void* const* d_in, const int* in_sizes, int n_in, void* d_out, int out_size, void* d_ws, size_t ws_size, hipStream_t stream) {
    static int grid = 0;
    if (grid == 0) {
        if (n_in != 18 || in_sizes[0] != MTOK * DM || out_size != MTOK * DM || ws_size < WS_END) {
            fprintf(stderr, "kernel_launch: unexpected shapes / workspace (n_in %d, in0 %d, out %d, ws %zu, need %zu); nothing launched\n", n_in, n_in > 0 ? in_sizes[0] : -1, out_size, ws_size, (size_t)WS_END);
            grid = -1; return; }
        int dev = 0, cus = 0, per_cu = 0;
        hipGetDevice(&dev);
        hipDeviceGetAttribute(&cus, hipDeviceAttributeMultiprocessorCount, dev);
        hipFuncSetAttribute((const void*)hymba_fwd, hipFuncAttributeMaxDynamicSharedMemorySize, LDS_BYTES);
        hipOccupancyMaxActiveBlocksPerMultiprocessor(&per_cu, (const void*)hymba_fwd, 512, LDS_BYTES);
        if (per_cu < 1) { fprintf(stderr, "kernel_launch: occupancy query says %d blocks per CU\n", per_cu); per_cu = 1; }
        grid = cus * 1;
        if (grid != 256) fprintf(stderr, "kernel_launch: %d CUs; P6 needs >= 256 workgroups\n", grid);
    }
    if (grid < 0) return;
    Args a{};
    for (int i = 0; i < 18; ++i) a.in[i] = (const float*)d_in[i];
    a.out = (float*)d_out; a.ws = (unsigned char*)d_ws;
#if MK_MULTI
    for (int p = 0; p < NPHASE; ++p) { a.ph_lo = p; a.ph_hi = p + 1;
        for (int rep = 0; rep < ((PROBE_DUP >> p) & 1 ? 2 : 1); ++rep) hipLaunchKernelGGL(hymba_fwd, dim3(grid), dim3(512), LDS_BYTES, stream, a); }
#else
    a.ph_lo = 0; a.ph_hi = NPHASE;
    (void)hipMemsetAsync((char*)d_ws + WS_CTL, 0, CTL_BYTES, stream);
    void* args[] = {&a};
    hipError_t e = hipLaunchCooperativeKernel((const void*)hymba_fwd, dim3(grid), dim3(512), args, LDS_BYTES, stream);
    if (e != hipSuccess) fprintf(stderr, "cooperative launch failed: %s (grid %d)\n", hipGetErrorString(e), grid);
#endif
}
```

```cpp
#include <hip/hip_runtime.h>
#include <hip/hip_cooperative_groups.h>
#include <cstdio>
#include <cstdint>
namespace cg = cooperative_groups;

#ifndef PROBE_DUP
#define PROBE_DUP 0
#endif
#ifndef MK_MULTI
#define MK_MULTI 0
#endif

#define LAS __attribute__((address_space(3)))
typedef unsigned short bf16_t;
typedef short bf16x8 __attribute__((ext_vector_type(8)));
typedef short s16x4 __attribute__((ext_vector_type(4)));
typedef float f32x4 __attribute__((ext_vector_type(4)));
typedef float f32x2 __attribute__((ext_vector_type(2)));
typedef float f32x16 __attribute__((ext_vector_type(16)));
typedef unsigned u32x4 __attribute__((ext_vector_type(4)));
typedef unsigned u32x2 __attribute__((ext_vector_type(2)));

constexpr int DM = 2048, NB = 8, SEQ = 2048, MTOK = NB * SEQ;
constexpr int MEML = 256, MROWS = NB * MEML;
constexpr int D_IN = 4608, D_FF = 5632, NQK = 3328, NVT = 1280;
constexpr float ALPHA = 1.189207115002721f;
constexpr float LN_EPS = 1e-5f, RMS_EPS = 1e-6f;
constexpr float LOG2E = 1.4426950408889634f;
constexpr int NPHASE = 13, NCS = 2048 + 11264;

constexpr size_t MiB = 1u << 20;
constexpr size_t WS_QK = 0;
constexpr size_t WS_VT = 104 * MiB;
constexpr size_t WS_QM = 0;
constexpr size_t WS_P = 64 * MiB;
constexpr size_t WS_OC = 96 * MiB;
constexpr size_t WS_F = 0;
constexpr size_t WS_Y = 176 * MiB;
constexpr size_t WS_ALL = 304 * MiB;
constexpr size_t WS_KM = 160 * MiB;
constexpr size_t WS_VMT = 168 * MiB;
constexpr size_t WS_WO = 410 * MiB, WS_WQM = 418 * MiB, WS_WOM = 426 * MiB;
constexpr size_t WS_WGU = 434 * MiB;
constexpr size_t WS_WD = 478 * MiB;
constexpr size_t WS_CTL = 500 * MiB, CTL_BYTES = 64 * 1024;
constexpr size_t WS_CSP = 501 * MiB;
constexpr size_t WS_CSF = 505 * MiB;
constexpr size_t WS_SP1 = 368 * MiB, WS_SP2 = 372 * MiB;
constexpr size_t WS_END = 506 * MiB;

typedef __bf16 bf16x2_t __attribute__((ext_vector_type(2)));
__device__ __forceinline__ unsigned cvt_pk_bf16(float lo, float hi) { const f32x2 v = {lo, hi}; const bf16x2_t b = __builtin_convertvector(v, bf16x2_t); return __builtin_bit_cast(unsigned, b); }
__device__ __forceinline__ float fexp2(float x) { return __builtin_amdgcn_exp2f(x); }
__device__ __forceinline__ float flog2(float x) { return __builtin_amdgcn_logf(x); }
__device__ __forceinline__ float wave_sum(float v) {
#pragma unroll
    for (int o = 1; o < 64; o <<= 1) v += __shfl_xor(v, o);
    return v;
}
#define LDS_WAIT() asm volatile("s_waitcnt lgkmcnt(0)" ::: "memory")

namespace pg8 {
constexpr int BM = 256, BK = 64, HALF = 128, HTB = HALF * BK * 2, STAGE_BYTES = 8 * HTB, NXCD = 8, WGM = 8;
__host__ __device__ __forceinline__ int lds_byte(int r, int c) { const int st = (r >> 4) * 2 + (c >> 5), rr = r & 15, cc = c & 31, ob = rr * 64 + cc * 2; return st * 1024 + (ob ^ (((ob >> 9) & 1) << 5)); }
__host__ __device__ __forceinline__ void stage_rc(int b, int& R, int& C) { const int st = b / 1024, sb = b % 1024, swz = sb ^ (((sb >> 9) & 1) << 5); R = (st >> 1) * 16 + swz / 64; C = (st & 1) * 32 + (swz % 64) / 2; }
__host__ __device__ __forceinline__ int perm32(int rho) { const int n = rho >> 4, i = rho & 15; return 8 * (i >> 2) + 4 * n + (i & 3); }

struct Unit { int pm, pn, z; };

__device__ __forceinline__ void map_tile(int l, int nM, int nN, int& pm, int& pn) {
    const int nwg = nM * nN; int wgid = l;
    { const int q = nwg / NXCD, r = nwg % NXCD, xcd = wgid % NXCD, off = wgid / NXCD; wgid = (xcd < r ? xcd * (q + 1) : r * (q + 1) + (xcd - r) * q) + off; }
    const int nig = WGM * nN, gid = wgid / nig, fm = gid * WGM, gsz = (nM - fm) < WGM ? (nM - fm) : WGM;
    pm = fm + ((wgid % nig) % gsz); pn = (wgid % nig) / gsz;
}

struct SchedPlain {
    const char* A; const char* Bt; int nM, nN, G, c; size_t tA, tB;
    __device__ void init(const bf16_t* A_, int lda, const bf16_t* B_, int ldb, int M, int N, int G_, int c_) { A = (const char*)A_; Bt = (const char*)B_; nM = M / BM; nN = N / BM; G = G_; c = c_; tA = (size_t)BM * lda * 2; tB = (size_t)BM * ldb * 2; }
    __device__ __forceinline__ bool next(int i, Unit& u) const { const long L = (long)i * G + c; if (L >= (long)nM * nN) return false; map_tile((int)L, nM, nN, u.pm, u.pn); u.z = 0; return true; }
    __device__ __forceinline__ const char* pa(const Unit& u) const { return A + (size_t)u.pm * tA; }
    __device__ __forceinline__ const char* pb(const Unit& u) const { return Bt + (size_t)u.pn * tB; }
};

struct SchedP1 {
    const char* all; int G, c;
    static constexpr size_t TB = (size_t)BM * DM * 2;
    __device__ __forceinline__ bool next(int i, Unit& u) const {
        const long L = (long)i * G + c; if (L >= 1280) return false;
        int l = (int)L;
        if (l < 832) { u.z = 0; map_tile(l, 64, 13, u.pm, u.pn); }
        else if (l < 1152) { u.z = 1; map_tile(l - 832, 5, 64, u.pm, u.pn); }
        else if (l < 1216) { u.z = 2; map_tile(l - 1152, 8, 8, u.pm, u.pn); }
        else { u.z = 3; map_tile(l - 1216, 8, 8, u.pm, u.pn); }
        return true;
    }
    __device__ __forceinline__ const char* pa(const Unit& u) const {
        const int t = u.z == 0 ? u.pm : (u.z == 1 ? 72 + (u.pm == 0 ? 5 : 13 + u.pm) : (u.z == 2 ? 64 + u.pm : 98 + u.pm));
        return all + (size_t)t * TB;
    }
    __device__ __forceinline__ const char* pb(const Unit& u) const {
        const int t = u.z == 0 ? 72 + (u.pn < 5 ? u.pn : u.pn + 1) : (u.z == 1 ? u.pn : (u.z == 2 ? 90 + u.pn : 64 + u.pn));
        return all + (size_t)t * TB;
    }
};

struct SchedQK {
    const char* Qm; const char* Km; int G, c;
    __device__ __forceinline__ bool next(int i, Unit& u) const { const long L = (long)i * G + c; if (L >= 256) return false; u.z = (int)L >> 3; u.pm = (int)L & 7; u.pn = 0; return true; }
    __device__ __forceinline__ const char* pa(const Unit& u) const { const int b = u.z >> 2, h = u.z & 3; return Qm + ((size_t)(b * SEQ + u.pm * 256) * DM + h * 512) * 2; }
    __device__ __forceinline__ const char* pb(const Unit& u) const { const int b = u.z >> 2, h = u.z & 3; return Km + ((size_t)(b * MEML) * DM + h * 512) * 2; }
};
struct SchedPV {
    const char* P; const char* Vt; int G, c;
    __device__ __forceinline__ bool next(int i, Unit& u) const { const long L = (long)i * G + c; if (L >= 512) return false; u.z = (int)L >> 4; u.pm = ((int)L >> 1) & 7; u.pn = (int)L & 1; return true; }
    __device__ __forceinline__ const char* pa(const Unit& u) const { return P + ((size_t)u.z * SEQ + u.pm * 256) * MEML * 2; }
    __device__ __forceinline__ const char* pb(const Unit& u) const { const int b = u.z >> 2, h = u.z & 3; return Vt + ((size_t)(h * 512 + u.pn * 256) * MROWS + b * MEML) * 2; }
};

typedef f32x4 Acc[2][2][4][2];
__device__ __forceinline__ void store_tile_bf16(const Acc& acc, bf16_t* base, size_t ldc, int wr, int wc, int fr, int fq) {
    bf16_t* p0 = base + (size_t)(wr * 64 + fr) * ldc + wc * 32 + 8 * fq;
#pragma unroll
    for (int ai = 0; ai < 2; ++ai)
#pragma unroll
        for (int m = 0; m < 4; ++m) { bf16_t* rowp = p0 + (size_t)(ai * HALF + m * 16) * ldc;
#pragma unroll
            for (int bj = 0; bj < 2; ++bj) { const f32x4 v0 = acc[ai][bj][m][0], v1 = acc[ai][bj][m][1]; u32x4 w;
                w.x = cvt_pk_bf16(v0[0], v0[1]); w.y = cvt_pk_bf16(v0[2], v0[3]); w.z = cvt_pk_bf16(v1[0], v1[1]); w.w = cvt_pk_bf16(v1[2], v1[3]);
                *(u32x4*)(rowp + bj * HALF) = w; } }
}
struct EpiP1 {
    static constexpr bool PERM = true, AFTER_DRAIN = false;
    bf16_t *QK, *VT, *KM, *VMT;
    __device__ __forceinline__ void operator()(const Acc& acc, const Unit& u, int wr, int wc, int fr, int fq) const {
        if (u.z == 0) {
            const int b = u.pm >> 3, hs0 = 4 * u.pn + (wc >> 1), hi = wc & 1;
#pragma unroll
            for (int ai = 0; ai < 2; ++ai)
#pragma unroll
                for (int m = 0; m < 4; ++m) { const int t = (u.pm & 7) * 256 + ai * HALF + wr * 64 + m * 16 + fr;
#pragma unroll
                    for (int bj = 0; bj < 2; ++bj) { const f32x4 v0 = acc[ai][bj][m][0], v1 = acc[ai][bj][m][1]; u32x4 w;
                        w.x = cvt_pk_bf16(v0[0], v0[1]); w.y = cvt_pk_bf16(v0[2], v0[3]); w.z = cvt_pk_bf16(v1[0], v1[1]); w.w = cvt_pk_bf16(v1[2], v1[3]);
                        const size_t off = ((((size_t)(b * 52 + hs0 + 2 * bj) * 64 + (t >> 5)) * 4 + fq) * 64 + hi * 32 + (t & 31)) * 8;
                        *(u32x4*)(QK + off) = w; } }
        } else if (u.z == 1) {
            const int b = u.pn >> 3, s = fq >> 1, half = fq & 1;
#pragma unroll
            for (int ai = 0; ai < 2; ++ai)
#pragma unroll
                for (int m = 0; m < 4; ++m) { const int vrow = u.pm * 256 + ai * HALF + wr * 64 + m * 16 + fr, vh = vrow >> 6, db = (vrow >> 5) & 1, dl = vrow & 31;
#pragma unroll
                    for (int bj = 0; bj < 2; ++bj) { const int blk = 8 * (u.pn & 7) + 4 * bj + wc;
                        const size_t off = ((((size_t)(b * 20 + vh) * 64 + blk) * 4 + db * 2 + s) * 64 + dl) * 8 + 4 * half;
#pragma unroll
                        for (int n = 0; n < 2; ++n) { const f32x4 v = acc[ai][bj][m][n]; u32x2 w; w.x = cvt_pk_bf16(v[0], v[1]); w.y = cvt_pk_bf16(v[2], v[3]);
                            *(u32x2*)(VT + off + n * 256) = w; } } }
        } else {
            bf16_t* base; size_t ldc;
            if (u.z == 2) { ldc = DM; base = KM + (size_t)(u.pm * 256) * ldc + u.pn * 256; }
            else { ldc = MROWS; base = VMT + (size_t)(u.pm * 256) * ldc + u.pn * 256; }
            store_tile_bf16(acc, base, ldc, wr, wc, fr, fq);
        }
    }
};
struct EpiPlain {
    static constexpr bool PERM = true, AFTER_DRAIN = false;
    bf16_t* O; int ldc;
    __device__ __forceinline__ void operator()(const Acc& acc, const Unit& u, int wr, int wc, int fr, int fq) const {
        store_tile_bf16(acc, O + (size_t)(u.pm * 256) * ldc + u.pn * 256, ldc, wr, wc, fr, fq);
    }
};
struct EpiPV {
    static constexpr bool PERM = true, AFTER_DRAIN = false;
    bf16_t* O;
    __device__ __forceinline__ void operator()(const Acc& acc, const Unit& u, int wr, int wc, int fr, int fq) const {
        const int b = u.z >> 2, h = u.z & 3;
        store_tile_bf16(acc, O + (size_t)(b * SEQ + u.pm * 256) * DM + h * 512 + u.pn * 256, DM, wr, wc, fr, fq);
    }
};
__device__ __forceinline__ void row_stats(const LAS f32x2* tab, int trow, float& mean, float& rstd) { const f32x2 s = tab[trow]; mean = s[0]; rstd = s[1]; }
struct EpiLnPlain {
    static constexpr bool PERM = true, AFTER_DRAIN = false;
    bf16_t* O; int ldc; const LAS f32x2* S; const float* cs; const float* bw;
    __device__ __forceinline__ void operator()(const Acc& acc, const Unit& u, int wr, int wc, int fr, int fq) const {
        const int colt = u.pn * 256 + wc * 32 + 8 * fq;
        bf16_t* p0 = O + (size_t)(u.pm * 256 + wr * 64 + fr) * ldc + colt;
#pragma unroll
        for (int ai = 0; ai < 2; ++ai)
#pragma unroll
            for (int m = 0; m < 4; ++m) { float mean, rstd; row_stats(S, ai * HALF + wr * 64 + m * 16 + fr, mean, rstd);
                bf16_t* rowp = p0 + (size_t)(ai * HALF + m * 16) * ldc;
#pragma unroll
                for (int bj = 0; bj < 2; ++bj) { const int col = colt + bj * HALF;
                    const f32x4 c0 = *(const f32x4*)(cs + col), c1 = *(const f32x4*)(cs + col + 4), b0 = *(const f32x4*)(bw + col), b1 = *(const f32x4*)(bw + col + 4);
                    const f32x4 v0 = (acc[ai][bj][m][0] - c0 * mean) * rstd + b0, v1 = (acc[ai][bj][m][1] - c1 * mean) * rstd + b1; u32x4 w;
                    w.x = cvt_pk_bf16(v0[0], v0[1]); w.y = cvt_pk_bf16(v0[2], v0[3]); w.z = cvt_pk_bf16(v1[0], v1[1]); w.w = cvt_pk_bf16(v1[2], v1[3]);
                    *(u32x4*)(rowp + bj * HALF) = w; } }
    }
};
template <int MODE> struct EpiRes {
    static constexpr bool PERM = true, AFTER_DRAIN = false;
    const float* X; bf16_t* Yb; const LAS f32x2* Sin; const float* g; const float* b; float* Sout;
    __device__ __forceinline__ void operator()(const Acc& acc, const Unit& u, int wr, int wc, int fr, int fq) const {
        const int col0 = u.pn * 256 + wc * 32 + 8 * fq;
#pragma unroll
        for (int ai = 0; ai < 2; ++ai)
#pragma unroll
            for (int m = 0; m < 4; ++m) { const int trow = ai * HALF + wr * 64 + m * 16 + fr, row = u.pm * 256 + trow; const size_t off = (size_t)row * DM + col0;
                float mean = 0.f, rstd = 1.f; if (MODE > 0) row_stats(Sin, trow, mean, rstd);
                f32x4 rv[2][2];
#pragma unroll
                for (int bj = 0; bj < 2; ++bj) { const int dc = bj * HALF;
                    if (MODE == 0) { rv[bj][0] = *(const f32x4*)(X + off + dc); rv[bj][1] = *(const f32x4*)(X + off + dc + 4); }
                    else { const u32x4 w = *(const u32x4*)(Yb + off + dc);
                        const f32x4 y0 = {__builtin_bit_cast(float, w.x << 16), __builtin_bit_cast(float, w.x & 0xffff0000u), __builtin_bit_cast(float, w.y << 16), __builtin_bit_cast(float, w.y & 0xffff0000u)};
                        const f32x4 y1 = {__builtin_bit_cast(float, w.z << 16), __builtin_bit_cast(float, w.z & 0xffff0000u), __builtin_bit_cast(float, w.w << 16), __builtin_bit_cast(float, w.w & 0xffff0000u)};
                        rv[bj][0] = (y0 - mean) * rstd * *(const f32x4*)(g + col0 + dc) + *(const f32x4*)(b + col0 + dc);
                        rv[bj][1] = (y1 - mean) * rstd * *(const f32x4*)(g + col0 + dc + 4) + *(const f32x4*)(b + col0 + dc + 4); } }
                float ps = 0.f, pq = 0.f;
#pragma unroll
                for (int bj = 0; bj < 2; ++bj) { const f32x4 y0 = rv[bj][0] * ALPHA + acc[ai][bj][m][0], y1 = rv[bj][1] * ALPHA + acc[ai][bj][m][1]; u32x4 w;
                    w.x = cvt_pk_bf16(y0[0], y0[1]); w.y = cvt_pk_bf16(y0[2], y0[3]); w.z = cvt_pk_bf16(y1[0], y1[1]); w.w = cvt_pk_bf16(y1[2], y1[3]);
                    *(u32x4*)(Yb + off + bj * HALF) = w;
                    if (MODE < 2) { ps += ((y0[0] + y0[1]) + (y0[2] + y0[3])) + ((y1[0] + y1[1]) + (y1[2] + y1[3]));
                        pq += ((y0[0] * y0[0] + y0[1] * y0[1]) + (y0[2] * y0[2] + y0[3] * y0[3])) + ((y1[0] * y1[0] + y1[1] * y1[1]) + (y1[2] * y1[2] + y1[3] * y1[3])); } }
                if (MODE < 2) { ps += __shfl_xor(ps, 16); ps += __shfl_xor(ps, 32); pq += __shfl_xor(pq, 16); pq += __shfl_xor(pq, 32);
                    if (fq == 0) *(f32x2*)(Sout + ((size_t)row * 32 + 4 * u.pn + wc) * 2) = (f32x2){ps, pq}; }
            }
    }
};
struct EpiSwiglu {
    static constexpr bool PERM = true, AFTER_DRAIN = false;
    bf16_t* F; const LAS f32x2* S; const float* cs; const float* bw;
    __device__ __forceinline__ void operator()(const Acc& acc, const Unit& u, int wr, int wc, int fr, int fq) const {
        bf16_t* p0 = F + (size_t)(u.pm * 256 + wr * 64 + fr) * D_FF + u.pn * 128 + wc * 32 + 8 * fq;
        const int colt = u.pn * 256 + wc * 32 + 8 * fq;
        f32x4 cg[2], cu[2], bg[2], bu[2];
#pragma unroll
        for (int n = 0; n < 2; ++n) { cg[n] = *(const f32x4*)(cs + colt + 4 * n); cu[n] = *(const f32x4*)(cs + colt + HALF + 4 * n); bg[n] = *(const f32x4*)(bw + colt + 4 * n); bu[n] = *(const f32x4*)(bw + colt + HALF + 4 * n); }
#pragma unroll
        for (int ai = 0; ai < 2; ++ai)
#pragma unroll
            for (int m = 0; m < 4; ++m) { float mean, rstd; row_stats(S, ai * HALF + wr * 64 + m * 16 + fr, mean, rstd); float o[8];
#pragma unroll
                for (int n = 0; n < 2; ++n) { const f32x4 gv = (acc[ai][0][m][n] - cg[n] * mean) * rstd + bg[n], uv = (acc[ai][1][m][n] - cu[n] * mean) * rstd + bu[n];
#pragma unroll
                    for (int j = 0; j < 4; ++j) o[n * 4 + j] = gv[j] * __builtin_amdgcn_rcpf(1.0f + fexp2(-gv[j] * LOG2E)) * uv[j]; }
                u32x4 w; w.x = cvt_pk_bf16(o[0], o[1]); w.y = cvt_pk_bf16(o[2], o[3]); w.z = cvt_pk_bf16(o[4], o[5]); w.w = cvt_pk_bf16(o[6], o[7]);
                *(u32x4*)(p0 + (size_t)(ai * HALF + m * 16) * D_FF) = w; }
    }
};
struct EpiSoftmax {
    static constexpr bool PERM = true, AFTER_DRAIN = true;
    bf16_t* P;
    __device__ __forceinline__ void fused(Acc& acc, const Unit& u, int wr, int wc, int fr, int fq, LAS unsigned char* lds, int wid, int lane) const {
        const float c = 0.04419417382415922f * LOG2E;
        LAS f32x2* T = (LAS f32x2*)lds;
        float mw[2][4];
#pragma unroll
        for (int ai = 0; ai < 2; ++ai)
#pragma unroll
            for (int m = 0; m < 4; ++m) {
                float mx = -INFINITY;
#pragma unroll
                for (int bj = 0; bj < 2; ++bj)
#pragma unroll
                    for (int n = 0; n < 2; ++n) { const f32x4 x = acc[ai][bj][m][n]; mx = fmaxf(mx, fmaxf(fmaxf(x[0], x[1]), fmaxf(x[2], x[3]))); }
                mx = fmaxf(mx, __shfl_xor(mx, 16)); mx = fmaxf(mx, __shfl_xor(mx, 32));
                float s = 0.f;
#pragma unroll
                for (int bj = 0; bj < 2; ++bj)
#pragma unroll
                    for (int n = 0; n < 2; ++n) { f32x4 x = acc[ai][bj][m][n];
#pragma unroll
                        for (int j = 0; j < 4; ++j) { x[j] = fexp2((x[j] - mx) * c); s += x[j]; }
                        acc[ai][bj][m][n] = x; }
                s += __shfl_xor(s, 16); s += __shfl_xor(s, 32);
                mw[ai][m] = mx;
                if (fq == 0) T[(ai * HALF + wr * 64 + m * 16 + fr) * 4 + wc] = (f32x2){mx, s};
            }
        LDS_WAIT(); __builtin_amdgcn_s_barrier(); asm volatile("" ::: "memory");
        bf16_t* p0 = P + ((size_t)u.z * SEQ + u.pm * 256 + wr * 64 + fr) * MEML + wc * 32 + 8 * fq;
#pragma unroll
        for (int ai = 0; ai < 2; ++ai)
#pragma unroll
            for (int m = 0; m < 4; ++m) { const int row = ai * HALF + wr * 64 + m * 16 + fr;
                const f32x2 t0 = T[row * 4 + 0], t1 = T[row * 4 + 1], t2 = T[row * 4 + 2], t3 = T[row * 4 + 3];
                const float M = fmaxf(fmaxf(t0.x, t1.x), fmaxf(t2.x, t3.x));
                const float tot = t0.y * fexp2((t0.x - M) * c) + t1.y * fexp2((t1.x - M) * c) + t2.y * fexp2((t2.x - M) * c) + t3.y * fexp2((t3.x - M) * c);
                const float f = fexp2((mw[ai][m] - M) * c) / tot;
                bf16_t* rowp = p0 + (size_t)(ai * HALF + m * 16) * MEML;
#pragma unroll
                for (int bj = 0; bj < 2; ++bj) { const f32x4 v0 = acc[ai][bj][m][0] * f, v1 = acc[ai][bj][m][1] * f; u32x4 w;
                    w.x = cvt_pk_bf16(v0[0], v0[1]); w.y = cvt_pk_bf16(v0[2], v0[3]); w.z = cvt_pk_bf16(v1[0], v1[1]); w.w = cvt_pk_bf16(v1[2], v1[3]);
                    *(u32x4*)(rowp + bj * HALF) = w; } }
    }
};

template <class Epi, class Sched, bool ALIGN_EPI>
__device__ __forceinline__ void gemm_phase(LAS unsigned char* lds, const int lda, const int ldb, const int K, const Sched& S, const Epi& E) {
    const int tid = threadIdx.x, wid = __builtin_amdgcn_readfirstlane(tid >> 6), lane = tid & 63, wr = wid >> 2, wc = wid & 3, fr = lane & 15, fq = lane >> 4;
    const int nt = K / BK;
    unsigned voffA[2], voffB[2];
#pragma unroll
    for (int i = 0; i < 2; ++i) { int R, C; stage_rc(tid * 16 + i * 8192, R, C); const int Rb = Epi::PERM ? ((R & ~31) + perm32(R & 31)) : R;
        voffA[i] = (unsigned)(R * lda + C) * 2u; voffB[i] = (unsigned)(Rb * ldb + C) * 2u; }
    const size_t kstep = (size_t)(BK * 2);
    const size_t hsA = (size_t)HALF * lda * 2, hsB = (size_t)HALF * ldb * 2;
    const unsigned ldsw = (unsigned)wid * 1024u;
    const int aoff = lds_byte(wr * 64 + fr, fq * 8), boff = lds_byte(wc * 32 + fr, fq * 8);
#define PG8_SA(b, h) (((b) * 2 + (h)) * HTB)
#define PG8_SB(b, h) ((4 + (b) * 2 + (h)) * HTB)
#define PG8_STAGE(bufoff, gbase, voff) do { _Pragma("unroll") for (int _i = 0; _i < 2; ++_i) \
        __builtin_amdgcn_global_load_lds((const unsigned*)((const char*)(gbase) + (voff)[_i]), (LAS unsigned*)(lds + (bufoff) + ldsw + _i * 8192), 16, 0, 0); } while (0)
#define PG8_LDA(dst, b, h) do { _Pragma("unroll") for (int m = 0; m < 4; ++m) _Pragma("unroll") for (int k = 0; k < 2; ++k) dst[m][k] = *(const LAS bf16x8*)(lds + PG8_SA(b, h) + aoff + m * 2048 + k * 1024); } while (0)
#define PG8_LDB(dst, b, h) do { _Pragma("unroll") for (int n = 0; n < 2; ++n) _Pragma("unroll") for (int k = 0; k < 2; ++k) dst[n][k] = *(const LAS bf16x8*)(lds + PG8_SB(b, h) + boff + n * 2048 + k * 1024); } while (0)
#define PG8_MMA(ai, bj, At, Bt) do { __builtin_amdgcn_s_setprio(1); _Pragma("unroll") for (int m = 0; m < 4; ++m) _Pragma("unroll") for (int n = 0; n < 2; ++n) _Pragma("unroll") for (int k = 0; k < 2; ++k) \
        acc[ai][bj][m][n] = __builtin_amdgcn_mfma_f32_16x16x32_bf16(Bt[n][k], At[m][k], acc[ai][bj][m][n], 0, 0, 0); __builtin_amdgcn_s_setprio(0); } while (0)
#define PG8_WAIT_V(n) asm volatile("s_waitcnt vmcnt(" #n ")" ::: "memory")
#define PG8_WAIT_L(n) asm volatile("s_waitcnt lgkmcnt(" #n ")" ::: "memory")
#define PG8_BAR __builtin_amdgcn_s_barrier()
#define PG8_SCHED __builtin_amdgcn_sched_barrier(0)
    Unit cur, nxt; int ui = 0;
    if (!S.next(0, cur)) return;
    Acc acc;
#pragma unroll
    for (int a = 0; a < 2; ++a)
#pragma unroll
        for (int b = 0; b < 2; ++b)
#pragma unroll
            for (int m = 0; m < 4; ++m)
#pragma unroll
                for (int n = 0; n < 2; ++n) acc[a][b][m][n] = (f32x4){0.f, 0.f, 0.f, 0.f};
    bf16x8 At[4][2], B0[2][2], B1[2][2];
    const char* cA = S.pa(cur); const char* cB = S.pb(cur);
    PG8_STAGE(PG8_SB(0, 0), cB, voffB); PG8_STAGE(PG8_SB(0, 1), cB + hsB, voffB); PG8_STAGE(PG8_SA(0, 0), cA, voffA); PG8_STAGE(PG8_SA(0, 1), cA + hsA, voffA);
    if (wr == 1) PG8_BAR;
    PG8_WAIT_V(2); PG8_BAR;
    PG8_STAGE(PG8_SB(1, 0), cB + kstep, voffB); PG8_STAGE(PG8_SA(1, 0), cA + kstep, voffA); PG8_STAGE(PG8_SB(1, 1), cB + hsB + kstep, voffB);
    PG8_WAIT_V(6); PG8_BAR;
    for (;;) {
        const bool has_next = S.next(ui + 1, nxt);
        const char* nA = has_next ? S.pa(nxt) : cA; const char* nB = has_next ? S.pb(nxt) : cB;
#pragma unroll 1
        for (int t = 0; t < nt; t += 2) {
            const bool last = (t == nt - 2);
            const char* a1 = cA + (size_t)(t + 1) * kstep;
            const char* a2 = last ? nA : cA + (size_t)(t + 2) * kstep; const char* b2 = last ? nB : cB + (size_t)(t + 2) * kstep;
            const char* a3 = a2 + kstep; const char* b3 = b2 + kstep;
            PG8_LDB(B0, 0, 0); PG8_LDB(B1, 0, 1); PG8_SCHED; PG8_LDA(At, 0, 0); PG8_STAGE(PG8_SA(1, 1), a1 + hsA, voffA);
            PG8_WAIT_V(8); PG8_WAIT_L(0); PG8_BAR; PG8_MMA(0, 0, At, B0); PG8_MMA(0, 1, At, B1); PG8_BAR; PG8_SCHED;
            PG8_LDA(At, 0, 1); PG8_STAGE(PG8_SB(0, 0), b2, voffB); PG8_STAGE(PG8_SB(0, 1), b2 + hsB, voffB); PG8_STAGE(PG8_SA(0, 0), a2, voffA);
            PG8_WAIT_V(8); PG8_WAIT_L(0); PG8_BAR; PG8_MMA(1, 0, At, B0); PG8_MMA(1, 1, At, B1); PG8_BAR; PG8_SCHED;
            PG8_LDB(B0, 1, 0); PG8_LDB(B1, 1, 1); PG8_SCHED; PG8_LDA(At, 1, 0); PG8_STAGE(PG8_SA(0, 1), a2 + hsA, voffA);
            PG8_WAIT_V(8); PG8_WAIT_L(0); PG8_BAR; PG8_MMA(0, 0, At, B0); PG8_MMA(0, 1, At, B1); PG8_BAR; PG8_SCHED;
            PG8_LDA(At, 1, 1); PG8_STAGE(PG8_SB(1, 0), b3, voffB); PG8_STAGE(PG8_SB(1, 1), b3 + hsB, voffB); PG8_STAGE(PG8_SA(1, 0), a3, voffA);
            PG8_WAIT_V(8); PG8_WAIT_L(0); PG8_BAR; PG8_MMA(1, 0, At, B0); PG8_MMA(1, 1, At, B1); PG8_BAR; PG8_SCHED;
        }
        if constexpr (ALIGN_EPI) { if (wr == 0) PG8_BAR; }
        if constexpr (!Epi::AFTER_DRAIN) { E(acc, cur, wr, wc, fr, fq); }
        if (!has_next) break;
#pragma unroll
        for (int a = 0; a < 2; ++a)
#pragma unroll
            for (int b = 0; b < 2; ++b)
#pragma unroll
                for (int m = 0; m < 4; ++m)
#pragma unroll
                    for (int n = 0; n < 2; ++n) acc[a][b][m][n] = (f32x4){0.f, 0.f, 0.f, 0.f};
        cur = nxt; cA = nA; cB = nB; ++ui;
        if constexpr (ALIGN_EPI) { if (wr == 1) PG8_BAR; }
    }
    PG8_WAIT_V(0);
    if constexpr (!ALIGN_EPI) { if (wr == 0) PG8_BAR; }
    PG8_BAR;
    if constexpr (Epi::AFTER_DRAIN) { E.fused(acc, cur, wr, wc, fr, fq, lds, wid, lane); }
#undef PG8_SA
#undef PG8_SB
#undef PG8_STAGE
#undef PG8_LDA
#undef PG8_LDB
#undef PG8_MMA
#undef PG8_WAIT_V
#undef PG8_WAIT_L
#undef PG8_BAR
#undef PG8_SCHED
}
}

__device__ __forceinline__ void transpose_item(const float* W, int N, bf16_t* WT, int ldt, int k0, int n0, int dest_row0, LAS float* scr, int lane) {
#pragma unroll 8
    for (int i = 0; i < 32; ++i) { const int kk = 2 * i + (lane >> 5); scr[kk * 33 + (lane & 31)] = W[(size_t)(k0 + kk) * N + n0 + (lane & 31)]; }
    LDS_WAIT(); asm volatile("" ::: "memory");
    const int c = lane & 7;
#pragma unroll
    for (int j = 0; j < 4; ++j) { const int n = (lane >> 3) + 8 * j; const LAS float* s = scr + (8 * c) * 33 + n;
        u32x4 o; o.x = cvt_pk_bf16(s[0 * 33], s[1 * 33]); o.y = cvt_pk_bf16(s[2 * 33], s[3 * 33]); o.z = cvt_pk_bf16(s[4 * 33], s[5 * 33]); o.w = cvt_pk_bf16(s[6 * 33], s[7 * 33]);
        *(u32x4*)(WT + (size_t)(dest_row0 + n) * ldt + k0 + 8 * c) = o; }
    LDS_WAIT(); asm volatile("" ::: "memory");
}

__device__ __forceinline__ void transpose_item_ln(const float* W, int N, bf16_t* WT, int ldt, int k0, int n0, int dest_row0, LAS float* scr, int lane, const float* g, const float* b, float* csp_out, float* bwp_out) {
    float csp = 0.f, bwp = 0.f;
#pragma unroll 8
    for (int i = 0; i < 32; ++i) { const int kk = 2 * i + (lane >> 5); const float w = W[(size_t)(k0 + kk) * N + n0 + (lane & 31)], wg = w * g[k0 + kk];
        scr[kk * 33 + (lane & 31)] = wg; csp += wg; bwp += w * b[k0 + kk]; }
    csp += __shfl_xor(csp, 32); bwp += __shfl_xor(bwp, 32);
    if (lane < 32) { csp_out[lane] = csp; bwp_out[lane] = bwp; }
    LDS_WAIT(); asm volatile("" ::: "memory");
    const int c = lane & 7;
#pragma unroll
    for (int j = 0; j < 4; ++j) { const int n = (lane >> 3) + 8 * j; const LAS float* s = scr + (8 * c) * 33 + n;
        u32x4 o; o.x = cvt_pk_bf16(s[0 * 33], s[1 * 33]); o.y = cvt_pk_bf16(s[2 * 33], s[3 * 33]); o.z = cvt_pk_bf16(s[4 * 33], s[5 * 33]); o.w = cvt_pk_bf16(s[6 * 33], s[7 * 33]);
        *(u32x4*)(WT + (size_t)(dest_row0 + n) * ldt + k0 + 8 * c) = o; }
    LDS_WAIT(); asm volatile("" ::: "memory");
}

__device__ __forceinline__ int crow(int r, int hi) { return (r & 3) + 8 * (r >> 2) + 4 * hi; }

__device__ __forceinline__ void load_k(bf16x8 (&kf)[4], const bf16_t* blk) {
#pragma unroll
    for (int s = 0; s < 4; ++s) kf[s] = *(const bf16x8*)(blk + 512 * s);
}
__device__ __forceinline__ void load_v(bf16x8 (&vf)[2][2], const bf16_t* blk) {
#pragma unroll
    for (int db = 0; db < 2; ++db)
#pragma unroll
        for (int s = 0; s < 2; ++s) vf[db][s] = *(const bf16x8*)(blk + 512 * (db * 2 + s));
}
__device__ __forceinline__ bf16x8 pack8(const float* p) {
    const unsigned a = cvt_pk_bf16(p[0], p[1]), b = cvt_pk_bf16(p[2], p[3]), c = cvt_pk_bf16(p[4], p[5]), d = cvt_pk_bf16(p[6], p[7]);
    u32x4 w = {a, b, c, d}; return __builtin_bit_cast(bf16x8, w);
}
__device__ __forceinline__ void rms_store(const f32x16& o0, const f32x16& o1, const float* g, bf16_t* Orow, int hi) {
    float ss = 0.f;
#pragma unroll
    for (int r = 0; r < 16; ++r) ss += o0[r] * o0[r] + o1[r] * o1[r];
    ss += __shfl_xor(ss, 32);
    const float rs = 1.0f / sqrtf(ss * (1.0f / 64.0f) + RMS_EPS);
#pragma unroll
    for (int db = 0; db < 2; ++db)
#pragma unroll
        for (int i = 0; i < 4; ++i) { const int d = 32 * db + 8 * i + 4 * hi; const f32x4 gg = *(const f32x4*)(g + d);
            const float a0 = (db ? o1[4 * i + 0] : o0[4 * i + 0]) * rs * gg[0], a1 = (db ? o1[4 * i + 1] : o0[4 * i + 1]) * rs * gg[1];
            const float a2 = (db ? o1[4 * i + 2] : o0[4 * i + 2]) * rs * gg[2], a3 = (db ? o1[4 * i + 3] : o0[4 * i + 3]) * rs * gg[3];
            u32x2 w; w.x = cvt_pk_bf16(a0, a1); w.y = cvt_pk_bf16(a2, a3); *(u32x2*)(Orow + d) = w; }
}

template <bool DIAG>
__device__ __forceinline__ void sb_block(const f32x16& st, float& R, int lim  , int hi, bf16x8& pb0, bf16x8& pb1) {
    float L[16], lb[16];
#pragma unroll
    for (int r = 0; r < 16; ++r) {
        const float z2 = st[r] * (0.125f * LOG2E);
        const float e = fexp2(-fabsf(z2));
        const float l2 = flog2(1.0f + e);
        float b = fminf(z2, 0.f) - l2;
        float l1 = b - z2;
        if (DIAG) { const bool valid = crow(r, hi) < lim; l1 = valid ? l1 : 0.f; b = valid ? b : -INFINITY; }
        L[r] = l1; lb[r] = b;
    }
    float gs[4], pg[4];
#pragma unroll
    for (int i = 0; i < 4; ++i) { gs[i] = (L[4 * i] + L[4 * i + 1]) + (L[4 * i + 2] + L[4 * i + 3]); pg[i] = __shfl_xor(gs[i], 32); }
    float p[16];
    float suf = R;
#pragma unroll
    for (int i = 3; i >= 0; --i) {
        float off = suf + (hi == 0 ? pg[i] : 0.f);
        p[4 * i + 3] = fexp2(lb[4 * i + 3] + off); off += L[4 * i + 3];
        p[4 * i + 2] = fexp2(lb[4 * i + 2] + off); off += L[4 * i + 2];
        p[4 * i + 1] = fexp2(lb[4 * i + 1] + off); off += L[4 * i + 1];
        p[4 * i + 0] = fexp2(lb[4 * i + 0] + off);
        suf += gs[i] + pg[i];
    }
    R = suf;
    pb0 = pack8(p); pb1 = pack8(p + 8);
}

__device__ __forceinline__ void sb_wave(const bf16_t* QK, const bf16_t* VT, bf16_t* O, const float* g_sb, int b, int h, int t0, int lane) {
    const int q = lane & 31, hi = lane >> 5;
    const size_t rowq = (size_t)(b * SEQ + t0 + q);
    const bf16_t* qblk = QK + ((size_t)(b * 52 + 20 + h) * 64) * 2048 + lane * 8;
    const bf16_t* kblk = QK + ((size_t)(b * 52 + 36 + h) * 64) * 2048 + lane * 8;
    const bf16_t* vblk = VT + ((size_t)(b * 20 + 4 + h) * 64) * 2048 + lane * 8;
    bf16x8 qf[4]; load_k(qf, qblk + (size_t)(t0 >> 5) * 2048);
    f32x16 o0, o1;
#pragma unroll
    for (int r = 0; r < 16; ++r) { o0[r] = 0.f; o1[r] = 0.f; }
    float R = 0.f;
    bf16x8 kf[4], kn[4], vf[2][2], pb0, pb1;
    load_k(kf, kblk + (size_t)(t0 >> 5) * 2048);
    for (int k0 = t0; k0 >= 0; k0 -= 32) {
        load_v(vf, vblk + (size_t)(k0 >> 5) * 2048);
        if (k0 >= 32) load_k(kn, kblk + (size_t)((k0 >> 5) - 1) * 2048);
        f32x16 st;
#pragma unroll
        for (int r = 0; r < 16; ++r) st[r] = 0.f;
#pragma unroll
        for (int s = 0; s < 4; ++s) st = __builtin_amdgcn_mfma_f32_32x32x16_bf16(kf[s], qf[s], st, 0, 0, 0);
        if (k0 == t0) sb_block<true>(st, R, q, hi, pb0, pb1); else sb_block<false>(st, R, 64, hi, pb0, pb1);
        o0 = __builtin_amdgcn_mfma_f32_32x32x16_bf16(vf[0][0], pb0, o0, 0, 0, 0);
        o0 = __builtin_amdgcn_mfma_f32_32x32x16_bf16(vf[0][1], pb1, o0, 0, 0, 0);
        o1 = __builtin_amdgcn_mfma_f32_32x32x16_bf16(vf[1][0], pb0, o1, 0, 0, 0);
        o1 = __builtin_amdgcn_mfma_f32_32x32x16_bf16(vf[1][1], pb1, o1, 0, 0, 0);
        if (__all(R < -150.0f)) break;
#pragma unroll
        for (int s = 0; s < 4; ++s) kf[s] = kn[s];
    }
    rms_store(o0, o1, g_sb + h * 64, O + rowq * DM + 1024 + h * 64, hi);
}

__device__ __forceinline__ void swa_wave(const bf16_t* QK, const bf16_t* VT, bf16_t* O, const float* g_swa, const float* sinks, int b, int hq, int t0, int lane) {
    const int q = lane & 31, hi = lane >> 5, kvh = hq >> 2;
    const size_t rowq = (size_t)(b * SEQ + t0 + q);
    const bf16_t* qblk = QK + ((size_t)(b * 52 + hq) * 64) * 2048 + lane * 8;
    const bf16_t* kblk = QK + ((size_t)(b * 52 + 16 + kvh) * 64) * 2048 + lane * 8;
    const bf16_t* vblk = VT + ((size_t)(b * 20 + kvh) * 64) * 2048 + lane * 8;
    bf16x8 qf[4]; load_k(qf, qblk + (size_t)(t0 >> 5) * 2048);
    const float slope2 = fexp2(-0.5f * (float)(hq + 1)) * LOG2E;
    const float sink2 = sinks[hq] * LOG2E;
    f32x16 st[5];
#pragma unroll
    for (int jb = 0; jb < 5; ++jb) {
        const int k0 = t0 - 128 + 32 * jb;
#pragma unroll
        for (int r = 0; r < 16; ++r) st[jb][r] = 0.f;
        if (k0 >= 0) { bf16x8 kf[4]; load_k(kf, kblk + (size_t)(k0 >> 5) * 2048);
#pragma unroll
            for (int s = 0; s < 4; ++s) st[jb] = __builtin_amdgcn_mfma_f32_32x32x16_bf16(kf[s], qf[s], st[jb], 0, 0, 0); }
    }
    float mx = sink2;
#pragma unroll
    for (int jb = 0; jb < 5; ++jb) {
        const int k0 = t0 - 128 + 32 * jb;
#pragma unroll
        for (int r = 0; r < 16; ++r) { const int dist = q + 128 - 32 * jb - crow(r, hi);
            const bool valid = (k0 >= 0) && (dist >= 0) && (dist < 128);
            const float sc = valid ? (st[jb][r] * (0.125f * LOG2E) - slope2 * (float)dist) : -INFINITY;
            st[jb][r] = sc; mx = fmaxf(mx, sc); }
    }
    mx = fmaxf(mx, __shfl_xor(mx, 32));
    float sum = 0.f;
#pragma unroll
    for (int jb = 0; jb < 5; ++jb)
#pragma unroll
        for (int r = 0; r < 16; ++r) { const float p = fexp2(st[jb][r] - mx); st[jb][r] = p; sum += p; }
    sum += __shfl_xor(sum, 32);
    const float inv = 1.0f / (sum + fexp2(sink2 - mx));
    f32x16 o0, o1;
#pragma unroll
    for (int r = 0; r < 16; ++r) { o0[r] = 0.f; o1[r] = 0.f; }
#pragma unroll
    for (int jb = 0; jb < 5; ++jb) {
        const int k0 = t0 - 128 + 32 * jb;
        if (k0 >= 0) { bf16x8 vf[2][2]; load_v(vf, vblk + (size_t)(k0 >> 5) * 2048);
            float p[16];
#pragma unroll
            for (int r = 0; r < 16; ++r) p[r] = st[jb][r] * inv;
            const bf16x8 pb0 = pack8(p), pb1 = pack8(p + 8);
            o0 = __builtin_amdgcn_mfma_f32_32x32x16_bf16(vf[0][0], pb0, o0, 0, 0, 0);
            o0 = __builtin_amdgcn_mfma_f32_32x32x16_bf16(vf[0][1], pb1, o0, 0, 0, 0);
            o1 = __builtin_amdgcn_mfma_f32_32x32x16_bf16(vf[1][0], pb0, o1, 0, 0, 0);
            o1 = __builtin_amdgcn_mfma_f32_32x32x16_bf16(vf[1][1], pb1, o1, 0, 0, 0); }
    }
    rms_store(o0, o1, g_swa + hq * 64, O + rowq * DM + hq * 64, hi);
}

__device__ __forceinline__ f32x4 bf4lo(const u32x4& w) { return (f32x4){__builtin_bit_cast(float, w.x << 16), __builtin_bit_cast(float, w.x & 0xffff0000u), __builtin_bit_cast(float, w.y << 16), __builtin_bit_cast(float, w.y & 0xffff0000u)}; }
__device__ __forceinline__ f32x4 bf4hi(const u32x4& w) { return (f32x4){__builtin_bit_cast(float, w.z << 16), __builtin_bit_cast(float, w.z & 0xffff0000u), __builtin_bit_cast(float, w.w << 16), __builtin_bit_cast(float, w.w & 0xffff0000u)}; }
__device__ __forceinline__ void ln_rows(const bf16_t* Y, const float* g, const float* bta, float* Hf, bf16_t* Hb, int gw, int ngw, int lane) {
    for (int row = gw; row < MTOK; row += ngw) {
        const u32x4* yr = (const u32x4*)(Y + (size_t)row * DM) + lane;
        f32x4 v[8]; float s = 0.f;
#pragma unroll
        for (int j = 0; j < 4; ++j) { const u32x4 w = yr[64 * j]; v[2 * j] = bf4lo(w); v[2 * j + 1] = bf4hi(w); }
#pragma unroll
        for (int j = 0; j < 8; ++j) s += (v[j][0] + v[j][1]) + (v[j][2] + v[j][3]);
        const float mean = wave_sum(s) * (1.0f / DM); float s2 = 0.f;
#pragma unroll
        for (int j = 0; j < 8; ++j) { v[j] = v[j] - mean; s2 += (v[j][0] * v[j][0] + v[j][1] * v[j][1]) + (v[j][2] * v[j][2] + v[j][3] * v[j][3]); }
        const float rstd = 1.0f / sqrtf(wave_sum(s2) * (1.0f / DM) + LN_EPS);
#pragma unroll
        for (int j = 0; j < 4; ++j) { const int e = 8 * (lane + 64 * j);
            const f32x4 g0 = *(const f32x4*)(g + e), g1 = *(const f32x4*)(g + e + 4), b0 = *(const f32x4*)(bta + e), b1 = *(const f32x4*)(bta + e + 4);
            const f32x4 o0 = v[2 * j] * rstd * g0 + b0, o1 = v[2 * j + 1] * rstd * g1 + b1;
            if (Hf) { *(f32x4*)(Hf + (size_t)row * DM + e) = o0; *(f32x4*)(Hf + (size_t)row * DM + e + 4) = o1; }
            if (Hb) { u32x4 w; w.x = cvt_pk_bf16(o0[0], o0[1]); w.y = cvt_pk_bf16(o0[2], o0[3]); w.z = cvt_pk_bf16(o1[0], o1[1]); w.w = cvt_pk_bf16(o1[2], o1[3]); *(u32x4*)(Hb + (size_t)row * DM + e) = w; } }
    }
}

#define XB_TMO      128
#define XB_XCNT(j)  (256  + 64 * (j))
#define XB_XSUB(j)  (1280 + 64 * (j))
#define XB_XGEN(j)  (2304 + 64 * (j))
#define XB_TOP      3328
#define XB_TOPGEN   3392
#define XCD_BAR_WORDS 3456
#define XB_SPIN_CAP (1u << 18)

__device__ __forceinline__ unsigned xb_ld(unsigned* p)              { return __hip_atomic_load(p, __ATOMIC_RELAXED, __HIP_MEMORY_SCOPE_AGENT); }
__device__ __forceinline__ unsigned xb_add(unsigned* p, unsigned v) { return __hip_atomic_fetch_add(p, v, __ATOMIC_RELAXED, __HIP_MEMORY_SCOPE_AGENT); }
__device__ __forceinline__ unsigned xb_xcc_id() { return (unsigned)__builtin_amdgcn_s_getreg((3 << 11) | 20) & 0xFu; }
#define XB_SPIN(cond, bar) do { unsigned _sp = 0; while (cond) { __builtin_amdgcn_s_sleep(1); \
    if ((++_sp & 255u) == 0u) { if (xb_ld(&(bar)[XB_TMO])) break; if (_sp > XB_SPIN_CAP) { atomicAdd(&(bar)[XB_TMO], 1u); break; } } } } while (0)

struct XcdBarrier {
    unsigned* bar; unsigned x;
    volatile LAS unsigned* st;
};

__device__ __forceinline__ XcdBarrier xcd_barrier_post(unsigned* bar, volatile LAS unsigned* st) {
    XcdBarrier b; b.bar = bar; b.x = xb_xcc_id(); b.st = st;
    if (threadIdx.x == 0) (void)xb_add(&bar[XB_XCNT(b.x)], 1u);
    return b;
}
__device__ __forceinline__ void xcd_barrier_complete(unsigned* bar, unsigned x, unsigned& nloc, unsigned& nx) {
    const unsigned G = gridDim.x * gridDim.y * gridDim.z;
    unsigned sum, cnt, mine, sp = 0u;
    for (;;) {
        sum = 0u; cnt = 0u; mine = 0u;
#pragma unroll
        for (unsigned j = 0; j < 16; ++j) { const unsigned c = xb_ld(&bar[XB_XCNT(j)]); sum += c; cnt += (c > 0u) ? 1u : 0u; mine = (j == x) ? c : mine; }
        if (sum == G) break;
        __builtin_amdgcn_s_sleep(1);
        if ((++sp & 255u) == 0u) { if (xb_ld(&bar[XB_TMO])) break; if (sp > XB_SPIN_CAP) { atomicAdd(&bar[XB_TMO], 1u); break; } }
    }
    nloc = mine > 0u ? mine : 1u; nx = cnt > 0u ? cnt : 1u;
}

__device__ __forceinline__ void xcd_barrier(const XcdBarrier& b) {
    asm volatile("s_waitcnt vmcnt(0)" ::: "memory");
    __syncthreads();
    if (threadIdx.x == 0) {
        unsigned* bar = b.bar;
        __builtin_amdgcn_s_waitcnt(0);
        unsigned nloc = b.st[0], nx = b.st[1];
        if (nloc == 0u) { xcd_barrier_complete(bar, b.x, nloc, nx); b.st[0] = nloc; b.st[1] = nx; }
        const unsigned old = xb_add(&bar[XB_XSUB(b.x)], 1u);
        const unsigned gen = old / nloc;
        if (old + 1u == (gen + 1u) * nloc) {
            __builtin_amdgcn_fence(__ATOMIC_RELEASE, "agent");
            asm volatile("s_waitcnt vmcnt(0)" ::: "memory");
            const unsigned og = xb_add(&bar[XB_TOP], 1u);
            const unsigned tg = og / nx;
            if (og + 1u == (tg + 1u) * nx) xb_add(&bar[XB_TOPGEN], 1u);
            else XB_SPIN(xb_ld(&bar[XB_TOPGEN]) == tg, bar);
            __builtin_amdgcn_fence(__ATOMIC_ACQUIRE, "agent");
            xb_add(&bar[XB_XGEN(b.x)], 1u);
            asm volatile("s_waitcnt vmcnt(0)" ::: "memory");
        } else {
            XB_SPIN(xb_ld(&bar[XB_XGEN(b.x)]) == gen, bar);
            __builtin_amdgcn_fence(__ATOMIC_ACQUIRE, "agent");
            asm volatile("s_waitcnt vmcnt(0)" ::: "memory");
        }
    }
    __syncthreads();
}


__device__ __forceinline__ void stats_table(const float* Sp, int pm, LAS f32x2* tab, int tid) {
    const int row = tid >> 1, half = tid & 1;
    const f32x4* p = (const f32x4*)(Sp + ((size_t)(pm * 256 + row) * 32 + half * 16) * 2);
    float s = 0.f, q = 0.f;
#pragma unroll
    for (int j = 0; j < 8; ++j) { const f32x4 v = p[j]; s += v[0] + v[2]; q += v[1] + v[3]; }
    s += __shfl_xor(s, 1); q += __shfl_xor(q, 1);
    const float mean = s * (1.0f / DM), var = q * (1.0f / DM) - mean * mean;
    if (half == 0) tab[row] = (f32x2){mean, 1.0f / sqrtf(var + LN_EPS)};
    __syncthreads();
}

struct Args { const float* in[18]; float* out; unsigned char* ws; int ph_lo, ph_hi; };
constexpr int LDS_BYTES = 147456;

__global__ void __launch_bounds__(512, 2) hymba_fwd(Args a) {
    extern __shared__ __attribute__((aligned(16))) unsigned char lds_raw[];
    LAS unsigned char* lds = (LAS unsigned char*)lds_raw;
    cg::grid_group grid = cg::this_grid();
    const int tid = threadIdx.x, lane = tid & 63, wave = __builtin_amdgcn_readfirstlane(tid >> 6);
    const int G = gridDim.x, c = blockIdx.x;
    const int gw = c * 8 + wave, ngw = G * 8;
    unsigned char* ws = a.ws;
    const float *x = a.in[0], *mem = a.in[1], *w_in = a.in[2], *sinks = a.in[3], *g_swa = a.in[4], *g_sb = a.in[5], *w_o = a.in[6], *ln1_g = a.in[7], *ln1_b = a.in[8],
                *w_q_mem = a.in[9], *w_kv_mem = a.in[10], *w_o_mem = a.in[11], *ln2_g = a.in[12], *ln2_b = a.in[13], *w_gate_up = a.in[14], *w_down = a.in[15], *ln3_g = a.in[16], *ln3_b = a.in[17];
    bf16_t* ALL = (bf16_t*)(ws + WS_ALL);
    bf16_t* Ob = ALL;
    bf16_t* Hb = ALL;
    bf16_t *QK = (bf16_t*)(ws + WS_QK), *VT = (bf16_t*)(ws + WS_VT), *KM = (bf16_t*)(ws + WS_KM), *VMT = (bf16_t*)(ws + WS_VMT);
    bf16_t *WoT = (bf16_t*)(ws + WS_WO), *WqmT = (bf16_t*)(ws + WS_WQM), *WomT = (bf16_t*)(ws + WS_WOM), *WguT = (bf16_t*)(ws + WS_WGU), *WdT = (bf16_t*)(ws + WS_WD);
    bf16_t *Qm = (bf16_t*)(ws + WS_QM), *Pm = (bf16_t*)(ws + WS_P), *Oc = (bf16_t*)(ws + WS_OC), *Fb = (bf16_t*)(ws + WS_F);
    bf16_t* Yb = (bf16_t*)(ws + WS_Y);
    float *SP1 = (float*)(ws + WS_SP1), *SP2 = (float*)(ws + WS_SP2);
    float *csp = (float*)(ws + WS_CSP), *csf = (float*)(ws + WS_CSF);
    const float *cs1 = csf, *bw1 = csf + NCS, *cs2 = csf + 2048, *bw2 = csf + NCS + 2048;
    LAS f32x2* tab = (LAS f32x2*)(lds + 131072 + 1024);
    float* Hf = a.out;
    const int lo = a.ph_lo, hi_ = a.ph_hi;
    volatile LAS unsigned* xst = (volatile LAS unsigned*)(lds + 131072);
    if (tid == 0) { xst[0] = 0u; xst[1] = 0u; }
    __syncthreads();
    XcdBarrier xbar; xbar.bar = (unsigned*)(ws + WS_CTL); xbar.x = 0; xbar.st = xst;
    if (hi_ - lo > 1) { xbar = xcd_barrier_post((unsigned*)(ws + WS_CTL), xst);
        grid.sync(); }
#ifdef ONLY
#define IN(k) ((k) == ONLY && lo <= (k) && (k) < hi_)
#else
#define IN(k) (lo <= (k) && (k) < hi_)
#endif
#define SEAM(k) do { if (IN(k) && IN((k) + 1)) { xcd_barrier(xbar); } } while (0)
#ifndef REPEAT
#define REPEAT (-1)
#endif
#define REP(k) for (int rep_ = 0; rep_ < ((k) == REPEAT ? 2 : 1); ++rep_, ((k) == REPEAT ? grid.sync() : (void)0))

    if (IN(0)) REP(0) {
        LAS float* scr = (LAS float*)(lds + wave * 16384);
        constexpr int I0 = 32 * 144, I1 = 32 * 128, I2 = 32 * 64, I5 = 32 * 352, I6 = 88 * 64;
        constexpr int NIT = I0 + I1 + 3 * I2 + I5 + I6;
        for (int it = gw; it < NIT; it += ngw) {
            int r = it;
            if (r < I0) { const int kb = r / 144, nb = r % 144; transpose_item(w_in, D_IN, ALL, DM, 64 * kb, 32 * nb, 18432 + 32 * nb, scr, lane); continue; } r -= I0;
            if (r < I1) { const int kb = r / 128, nb = r % 128; transpose_item(w_kv_mem, 4096, ALL, DM, 64 * kb, 32 * nb, 23040 + 32 * nb, scr, lane); continue; } r -= I1;
            if (r < I2) { const int kb = r / 64, nb = r % 64; transpose_item(w_o, DM, WoT, DM, 64 * kb, 32 * nb, 32 * nb, scr, lane); continue; } r -= I2;
            if (r < I2) { const int kb = r / 64, nb = r % 64; transpose_item_ln(w_q_mem, DM, WqmT, DM, 64 * kb, 32 * nb, 32 * nb, scr, lane, ln1_g, ln1_b, csp + (size_t)(kb * 2) * NCS + 32 * nb, csp + (size_t)(kb * 2 + 1) * NCS + 32 * nb); continue; } r -= I2;
            if (r < I2) { const int kb = r / 64, nb = r % 64; transpose_item(w_o_mem, DM, WomT, DM, 64 * kb, 32 * nb, 32 * nb, scr, lane); continue; } r -= I2;
            if (r < I5) { const int kb = r / 352, nb = r % 352; const int n0 = 32 * nb, part = n0 >= D_FF ? 1 : 0, j = n0 - part * D_FF;
                const int dr = 256 * (j >> 7) + 128 * part + (j & 127); transpose_item_ln(w_gate_up, 2 * D_FF, WguT, DM, 64 * kb, n0, dr, scr, lane, ln2_g, ln2_b, csp + (size_t)(kb * 2) * NCS + 2048 + dr, csp + (size_t)(kb * 2 + 1) * NCS + 2048 + dr); continue; } r -= I5;
            { const int kb = r / 64, nb = r % 64; transpose_item(w_down, DM, WdT, D_FF, 64 * kb, 32 * nb, 32 * nb, scr, lane); }
        }
        const size_t nx8 = (size_t)MTOK * DM / 8, nm8 = (size_t)MROWS * DM / 8;
        for (size_t i = (size_t)c * 512 + tid; i < nx8 + nm8; i += (size_t)G * 512) {
            const float* src = i < nx8 ? x + i * 8 : mem + (i - nx8) * 8;
            const f32x4 v0 = *(const f32x4*)src, v1 = *(const f32x4*)(src + 4);
            u32x4 w; w.x = cvt_pk_bf16(v0[0], v0[1]); w.y = cvt_pk_bf16(v0[2], v0[3]); w.z = cvt_pk_bf16(v1[0], v1[1]); w.w = cvt_pk_bf16(v1[2], v1[3]);
            *(u32x4*)(ALL + i * 8) = w;
        }
    }
    SEAM(0);
    if (IN(1)) REP(1) {
        pg8::SchedP1 S{(const char*)ALL, G, c};
        pg8::EpiP1 E{QK, VT, KM, VMT};
        pg8::gemm_phase<pg8::EpiP1, pg8::SchedP1, true>(lds, DM, DM, DM, S, E);
    }
    SEAM(1);
    if (IN(2)) REP(2) {
        if (G == 256) {
            const int pair = c >> 1, b = pair >> 4, h = pair & 15;
#pragma unroll 1
            for (int j = 0; j < 4; ++j) {
                const int qb = (c & 1) ? (j == 0 ? 1 : (j == 1 ? 6 : (j == 2 ? 3 : 4))) : (j == 0 ? 0 : (j == 1 ? 7 : (j == 2 ? 2 : 5)));
                const int w = (j & 1) ? 7 - wave : wave;
                sb_wave(QK, VT, Ob, g_sb, b, h, 256 * qb + 32 * w, lane);
            }
        } else {
            for (int u = gw; u < NB * 16 * 64; u += ngw) sb_wave(QK, VT, Ob, g_sb, u >> 10, (u >> 6) & 15, 32 * (u & 63), lane);
        }
        for (int u = gw; u < NB * 16 * 64; u += ngw) swa_wave(QK, VT, Ob, g_swa, sinks, u >> 10, (u >> 6) & 15, 32 * (u & 63), lane);
    }
    SEAM(2);
    if (IN(3)) {
        for (int i = c * 512 + tid; i < 2 * NCS; i += G * 512) { float acc_ = 0.f;
#pragma unroll 8
            for (int kb = 0; kb < 32; ++kb) acc_ += csp[(size_t)kb * 2 * NCS + i];
            csf[i] = acc_; }
    }
    if (IN(3)) {
        pg8::SchedPlain S; S.init(Ob, DM, WoT, DM, MTOK, DM, G, c);
        pg8::EpiRes<0> E{x, Yb, nullptr, nullptr, nullptr, SP1};
        pg8::gemm_phase<pg8::EpiRes<0>, pg8::SchedPlain, true>(lds, DM, DM, DM, S, E);
    }
    SEAM(3);
    if (IN(5)) {
        pg8::SchedPlain S; S.init(Yb, DM, WqmT, DM, MTOK, DM, G, c);
        { pg8::Unit u0; int pm0 = 0; if (S.next(0, u0)) pm0 = u0.pm; stats_table(SP1, pm0, tab, tid); }
        pg8::EpiLnPlain E{Qm, DM, tab, cs1, bw1};
        pg8::gemm_phase<pg8::EpiLnPlain, pg8::SchedPlain, true>(lds, DM, DM, DM, S, E);
    }
    SEAM(5);
    if (IN(6)) {
        pg8::SchedQK S{(const char*)Qm, (const char*)KM, G, c};
        pg8::EpiSoftmax E{Pm};
        pg8::gemm_phase<pg8::EpiSoftmax, pg8::SchedQK, false>(lds, DM, DM, 512, S, E);
    }
    SEAM(6);
    if (IN(7)) {
        pg8::SchedPV S{(const char*)Pm, (const char*)VMT, G, c};
        pg8::EpiPV E{Oc};
        pg8::gemm_phase<pg8::EpiPV, pg8::SchedPV, true>(lds, MEML, MROWS, MEML, S, E);
    }
    SEAM(7);
    if (IN(8)) {
        pg8::SchedPlain S; S.init(Oc, DM, WomT, DM, MTOK, DM, G, c);
        { pg8::Unit u0; int pm0 = 0; if (S.next(0, u0)) pm0 = u0.pm; stats_table(SP1, pm0, tab, tid); }
        pg8::EpiRes<1> E{nullptr, Yb, tab, ln1_g, ln1_b, SP2};
        pg8::gemm_phase<pg8::EpiRes<1>, pg8::SchedPlain, true>(lds, DM, DM, DM, S, E);
    }
    SEAM(8);
    if (IN(10)) {
        pg8::SchedPlain S; S.init(Yb, DM, WguT, DM, MTOK, 2 * D_FF, G, c);
        { pg8::Unit u0; int pm0 = 0; if (S.next(0, u0)) pm0 = u0.pm; stats_table(SP2, pm0, tab, tid); }
        pg8::EpiSwiglu E{Fb, tab, cs2, bw2};
        pg8::gemm_phase<pg8::EpiSwiglu, pg8::SchedPlain, true>(lds, DM, DM, DM, S, E);
    }
    SEAM(10);
    if (IN(11)) {
        pg8::SchedPlain S; S.init(Fb, D_FF, WdT, D_FF, MTOK, DM, G, c);
        { pg8::Unit u0; int pm0 = 0; if (S.next(0, u0)) pm0 = u0.pm; stats_table(SP2, pm0, tab, tid); }
        pg8::EpiRes<2> E{nullptr, Yb, tab, ln2_g, ln2_b, nullptr};
        pg8::gemm_phase<pg8::EpiRes<2>, pg8::SchedPlain, true>(lds, D_FF, D_FF, D_FF, S, E);
    }
    SEAM(11);
    if (IN(12)) ln_rows(Yb, ln3_g, ln3_b, a.out, nullptr, gw, ngw, lane);
#undef IN
#undef SEAM
}

extern "C" void kernel_launch(void* const* d_in, const int* in_sizes, int n_in, void* d_out, int out_size, void* d_ws, size_t ws_size, hipStream_t stream) {
    static int grid = 0;
    if (grid == 0) {
        if (n_in != 18 || in_sizes[0] != MTOK * DM || out_size != MTOK * DM || ws_size < WS_END) {
            fprintf(stderr, "kernel_launch: unexpected shapes / workspace (n_in %d, in0 %d, out %d, ws %zu, need %zu); nothing launched\n", n_in, n_in > 0 ? in_sizes[0] : -1, out_size, ws_size, (size_t)WS_END);
            grid = -1; return; }
        int dev = 0, cus = 0, per_cu = 0;
        hipGetDevice(&dev);
        hipDeviceGetAttribute(&cus, hipDeviceAttributeMultiprocessorCount, dev);
        hipFuncSetAttribute((const void*)hymba_fwd, hipFuncAttributeMaxDynamicSharedMemorySize, LDS_BYTES);
        hipOccupancyMaxActiveBlocksPerMultiprocessor(&per_cu, (const void*)hymba_fwd, 512, LDS_BYTES);
        if (per_cu < 1) { fprintf(stderr, "kernel_launch: occupancy query says %d blocks per CU\n", per_cu); per_cu = 1; }
        grid = cus * 1;
        if (grid != 256) fprintf(stderr, "kernel_launch: %d CUs; P6 needs >= 256 workgroups\n", grid);
    }
    if (grid < 0) return;
    Args a{};
    for (int i = 0; i < 18; ++i) a.in[i] = (const float*)d_in[i];
    a.out = (float*)d_out; a.ws = (unsigned char*)d_ws;
#if MK_MULTI
    for (int p = 0; p < NPHASE; ++p) { a.ph_lo = p; a.ph_hi = p + 1;
        for (int rep = 0; rep < ((PROBE_DUP >> p) & 1 ? 2 : 1); ++rep) hipLaunchKernelGGL(hymba_fwd, dim3(grid), dim3(512), LDS_BYTES, stream, a); }
#else
    a.ph_lo = 0; a.ph_hi = NPHASE;
    (void)hipMemsetAsync((char*)d_ws + WS_CTL, 0, CTL_BYTES, stream);
    void* args[] = {&a};
    hipError_t e = hipLaunchCooperativeKernel((const void*)hymba_fwd, dim3(grid), dim3(512), args, LDS_BYTES, stream);
    if (e != hipSuccess) fprintf(stderr, "cooperative launch failed: %s (grid %d)\n", hipGetErrorString(e), grid);
#endif
}
```

```cpp
#include <hip/hip_runtime.h>
#include <hip/hip_cooperative_groups.h>
#include <cstdio>
#include <cstdint>
namespace cg = cooperative_groups;

#ifndef PROBE_DUP
#define PROBE_DUP 0
#endif
#ifndef MK_MULTI
#define MK_MULTI 0
#endif

#define LAS __attribute__((address_space(3)))
typedef unsigned short bf16_t;
typedef short bf16x8 __attribute__((ext_vector_type(8)));
typedef short s16x4 __attribute__((ext_vector_type(4)));
typedef float f32x4 __attribute__((ext_vector_type(4)));
typedef float f32x2 __attribute__((ext_vector_type(2)));
typedef float f32x16 __attribute__((ext_vector_type(16)));
typedef unsigned u32x4 __attribute__((ext_vector_type(4)));
typedef unsigned u32x2 __attribute__((ext_vector_type(2)));

constexpr int DM = 2048, NB = 8, SEQ = 2048, MTOK = NB * SEQ;
constexpr int MEML = 256, MROWS = NB * MEML;
constexpr int D_IN = 4608, D_FF = 5632, NQK = 3328, NVT = 1280;
constexpr float ALPHA = 1.189207115002721f;
constexpr float LN_EPS = 1e-5f, RMS_EPS = 1e-6f;
constexpr float LOG2E = 1.4426950408889634f;
constexpr int NPHASE = 13, NCS = 2048 + 11264;

constexpr size_t MiB = 1u << 20;
constexpr size_t WS_QK = 0;
constexpr size_t WS_VT = 104 * MiB;
constexpr size_t WS_QM = 0;
constexpr size_t WS_P = 64 * MiB;
constexpr size_t WS_OC = 96 * MiB;
constexpr size_t WS_F = 0;
constexpr size_t WS_Y = 176 * MiB;
constexpr size_t WS_ALL = 304 * MiB;
constexpr size_t WS_KM = 160 * MiB;
constexpr size_t WS_VMT = 168 * MiB;
constexpr size_t WS_WO = 410 * MiB, WS_WQM = 418 * MiB, WS_WOM = 426 * MiB;
constexpr size_t WS_WGU = 434 * MiB;
constexpr size_t WS_WD = 478 * MiB;
constexpr size_t WS_CTL = 500 * MiB, CTL_BYTES = 64 * 1024;
constexpr size_t WS_CSP = 501 * MiB;
constexpr size_t WS_CSF = 505 * MiB;
constexpr size_t WS_SP1 = 368 * MiB, WS_SP2 = 372 * MiB;
constexpr size_t WS_END = 506 * MiB;

typedef __bf16 bf16x2_t __attribute__((ext_vector_type(2)));
__device__ __forceinline__ unsigned cvt_pk_bf16(float lo, float hi) { const f32x2 v = {lo, hi}; const bf16x2_t b = __builtin_convertvector(v, bf16x2_t); return __builtin_bit_cast(unsigned, b); }
__device__ __forceinline__ float fexp2(float x) { return __builtin_amdgcn_exp2f(x); }
__device__ __forceinline__ float flog2(float x) { return __builtin_amdgcn_logf(x); }
__device__ __forceinline__ float wave_sum(float v) {
#pragma unroll
    for (int o = 1; o < 64; o <<= 1) v += __shfl_xor(v, o);
    return v;
}
#define LDS_WAIT() asm volatile("s_waitcnt lgkmcnt(0)" ::: "memory")

namespace pg8 {
constexpr int BM = 256, BK = 64, HALF = 128, HTB = HALF * BK * 2, STAGE_BYTES = 8 * HTB, NXCD = 8, WGM = 8;
__host__ __device__ __forceinline__ int lds_byte(int r, int c) { const int st = (r >> 4) * 2 + (c >> 5), rr = r & 15, cc = c & 31, ob = rr * 64 + cc * 2; return st * 1024 + (ob ^ (((ob >> 9) & 1) << 5)); }
__host__ __device__ __forceinline__ void stage_rc(int b, int& R, int& C) { const int st = b / 1024, sb = b % 1024, swz = sb ^ (((sb >> 9) & 1) << 5); R = (st >> 1) * 16 + swz / 64; C = (st & 1) * 32 + (swz % 64) / 2; }
__host__ __device__ __forceinline__ int perm32(int rho) { const int n = rho >> 4, i = rho & 15; return 8 * (i >> 2) + 4 * n + (i & 3); }

struct Unit { int pm, pn, z; };

__device__ __forceinline__ void map_tile(int l, int nM, int nN, int& pm, int& pn) {
    const int nwg = nM * nN; int wgid = l;
    { const int q = nwg / NXCD, r = nwg % NXCD, xcd = wgid % NXCD, off = wgid / NXCD; wgid = (xcd < r ? xcd * (q + 1) : r * (q + 1) + (xcd - r) * q) + off; }
    const int nig = WGM * nN, gid = wgid / nig, fm = gid * WGM, gsz = (nM - fm) < WGM ? (nM - fm) : WGM;
    pm = fm + ((wgid % nig) % gsz); pn = (wgid % nig) / gsz;
}

struct SchedPlain {
    const char* A; const char* Bt; int nM, nN, G, c; size_t tA, tB;
    __device__ void init(const bf16_t* A_, int lda, const bf16_t* B_, int ldb, int M, int N, int G_, int c_) { A = (const char*)A_; Bt = (const char*)B_; nM = M / BM; nN = N / BM; G = G_; c = c_; tA = (size_t)BM * lda * 2; tB = (size_t)BM * ldb * 2; }
    __device__ __forceinline__ bool next(int i, Unit& u) const { const long L = (long)i * G + c; if (L >= (long)nM * nN) return false; map_tile((int)L, nM, nN, u.pm, u.pn); u.z = 0; return true; }
    __device__ __forceinline__ const char* pa(const Unit& u) const { return A + (size_t)u.pm * tA; }
    __device__ __forceinline__ const char* pb(const Unit& u) const { return Bt + (size_t)u.pn * tB; }
};

struct SchedP1 {
    const char* all; int G, c;
    static constexpr size_t TB = (size_t)BM * DM * 2;
    __device__ __forceinline__ bool next(int i, Unit& u) const {
        const long L = (long)i * G + c; if (L >= 1280) return false;
        int l = (int)L;
        if (l < 832) { u.z = 0; map_tile(l, 64, 13, u.pm, u.pn); }
        else if (l < 1152) { u.z = 1; map_tile(l - 832, 5, 64, u.pm, u.pn); }
        else if (l < 1216) { u.z = 2; map_tile(l - 1152, 8, 8, u.pm, u.pn); }
        else { u.z = 3; map_tile(l - 1216, 8, 8, u.pm, u.pn); }
        return true;
    }
    __device__ __forceinline__ const char* pa(const Unit& u) const {
        const int t = u.z == 0 ? u.pm : (u.z == 1 ? 72 + (u.pm == 0 ? 5 : 13 + u.pm) : (u.z == 2 ? 64 + u.pm : 98 + u.pm));
        return all + (size_t)t * TB;
    }
    __device__ __forceinline__ const char* pb(const Unit& u) const {
        const int t = u.z == 0 ? 72 + (u.pn < 5 ? u.pn : u.pn + 1) : (u.z == 1 ? u.pn : (u.z == 2 ? 90 + u.pn : 64 + u.pn));
        return all + (size_t)t * TB;
    }
};

struct SchedQK {
    const char* Qm; const char* Km; int G, c;
    __device__ __forceinline__ bool next(int i, Unit& u) const { const long L = (long)i * G + c; if (L >= 256) return false; u.z = (int)L >> 3; u.pm = (int)L & 7; u.pn = 0; return true; }
    __device__ __forceinline__ const char* pa(const Unit& u) const { const int b = u.z >> 2, h = u.z & 3; return Qm + ((size_t)(b * SEQ + u.pm * 256) * DM + h * 512) * 2; }
    __device__ __forceinline__ const char* pb(const Unit& u) const { const int b = u.z >> 2, h = u.z & 3; return Km + ((size_t)(b * MEML) * DM + h * 512) * 2; }
};
struct SchedPV {
    const char* P; const char* Vt; int G, c;
    __device__ __forceinline__ bool next(int i, Unit& u) const { const long L = (long)i * G + c; if (L >= 512) return false; u.z = (int)L >> 4; u.pm = ((int)L >> 1) & 7; u.pn = (int)L & 1; return true; }
    __device__ __forceinline__ const char* pa(const Unit& u) const { return P + ((size_t)u.z * SEQ + u.pm * 256) * MEML * 2; }
    __device__ __forceinline__ const char* pb(const Unit& u) const { const int b = u.z >> 2, h = u.z & 3; return Vt + ((size_t)(h * 512 + u.pn * 256) * MROWS + b * MEML) * 2; }
};

typedef f32x4 Acc[2][2][4][2];
__device__ __forceinline__ void store_tile_bf16(const Acc& acc, bf16_t* base, size_t ldc, int wr, int wc, int fr, int fq) {
    bf16_t* p0 = base + (size_t)(wr * 64 + fr) * ldc + wc * 32 + 8 * fq;
#pragma unroll
    for (int ai = 0; ai < 2; ++ai)
#pragma unroll
        for (int m = 0; m < 4; ++m) { bf16_t* rowp = p0 + (size_t)(ai * HALF + m * 16) * ldc;
#pragma unroll
            for (int bj = 0; bj < 2; ++bj) { const f32x4 v0 = acc[ai][bj][m][0], v1 = acc[ai][bj][m][1]; u32x4 w;
                w.x = cvt_pk_bf16(v0[0], v0[1]); w.y = cvt_pk_bf16(v0[2], v0[3]); w.z = cvt_pk_bf16(v1[0], v1[1]); w.w = cvt_pk_bf16(v1[2], v1[3]);
                *(u32x4*)(rowp + bj * HALF) = w; } }
}
struct EpiP1 {
    static constexpr bool PERM = true, AFTER_DRAIN = false;
    bf16_t *QK, *VT, *KM, *VMT;
    __device__ __forceinline__ void operator()(const Acc& acc, const Unit& u, int wr, int wc, int fr, int fq) const {
        if (u.z == 0) {
            const int b = u.pm >> 3, hs0 = 4 * u.pn + (wc >> 1), hi = wc & 1;
#pragma unroll
            for (int ai = 0; ai < 2; ++ai)
#pragma unroll
                for (int m = 0; m < 4; ++m) { const int t = (u.pm & 7) * 256 + ai * HALF + wr * 64 + m * 16 + fr;
#pragma unroll
                    for (int bj = 0; bj < 2; ++bj) { const f32x4 v0 = acc[ai][bj][m][0], v1 = acc[ai][bj][m][1]; u32x4 w;
                        w.x = cvt_pk_bf16(v0[0], v0[1]); w.y = cvt_pk_bf16(v0[2], v0[3]); w.z = cvt_pk_bf16(v1[0], v1[1]); w.w = cvt_pk_bf16(v1[2], v1[3]);
                        const size_t off = ((((size_t)(b * 52 + hs0 + 2 * bj) * 64 + (t >> 5)) * 4 + fq) * 64 + hi * 32 + (t & 31)) * 8;
                        *(u32x4*)(QK + off) = w; } }
        } else if (u.z == 1) {
            const int b = u.pn >> 3, s = fq >> 1, half = fq & 1;
#pragma unroll
            for (int ai = 0; ai < 2; ++ai)
#pragma unroll
                for (int m = 0; m < 4; ++m) { const int vrow = u.pm * 256 + ai * HALF + wr * 64 + m * 16 + fr, vh = vrow >> 6, db = (vrow >> 5) & 1, dl = vrow & 31;
#pragma unroll
                    for (int bj = 0; bj < 2; ++bj) { const int blk = 8 * (u.pn & 7) + 4 * bj + wc;
                        const size_t off = ((((size_t)(b * 20 + vh) * 64 + blk) * 4 + db * 2 + s) * 64 + dl) * 8 + 4 * half;
#pragma unroll
                        for (int n = 0; n < 2; ++n) { const f32x4 v = acc[ai][bj][m][n]; u32x2 w; w.x = cvt_pk_bf16(v[0], v[1]); w.y = cvt_pk_bf16(v[2], v[3]);
                            *(u32x2*)(VT + off + n * 256) = w; } } }
        } else {
            bf16_t* base; size_t ldc;
            if (u.z == 2) { ldc = DM; base = KM + (size_t)(u.pm * 256) * ldc + u.pn * 256; }
            else { ldc = MROWS; base = VMT + (size_t)(u.pm * 256) * ldc + u.pn * 256; }
            store_tile_bf16(acc, base, ldc, wr, wc, fr, fq);
        }
    }
};
struct EpiPlain {
    static constexpr bool PERM = true, AFTER_DRAIN = false;
    bf16_t* O; int ldc;
    __device__ __forceinline__ void operator()(const Acc& acc, const Unit& u, int wr, int wc, int fr, int fq) const {
        store_tile_bf16(acc, O + (size_t)(u.pm * 256) * ldc + u.pn * 256, ldc, wr, wc, fr, fq);
    }
};
struct EpiPV {
    static constexpr bool PERM = true, AFTER_DRAIN = false;
    bf16_t* O;
    __device__ __forceinline__ void operator()(const Acc& acc, const Unit& u, int wr, int wc, int fr, int fq) const {
        const int b = u.z >> 2, h = u.z & 3;
        store_tile_bf16(acc, O + (size_t)(b * SEQ + u.pm * 256) * DM + h * 512 + u.pn * 256, DM, wr, wc, fr, fq);
    }
};
__device__ __forceinline__ void row_stats(const LAS f32x2* tab, int trow, float& mean, float& rstd) { const f32x2 s = tab[trow]; mean = s[0]; rstd = s[1]; }
struct EpiLnPlain {
    static constexpr bool PERM = true, AFTER_DRAIN = false;
    bf16_t* O; int ldc; const LAS f32x2* S; const float* cs; const float* bw;
    __device__ __forceinline__ void operator()(const Acc& acc, const Unit& u, int wr, int wc, int fr, int fq) const {
        const int colt = u.pn * 256 + wc * 32 + 8 * fq;
        bf16_t* p0 = O + (size_t)(u.pm * 256 + wr * 64 + fr) * ldc + colt;
#pragma unroll
        for (int ai = 0; ai < 2; ++ai)
#pragma unroll
            for (int m = 0; m < 4; ++m) { float mean, rstd; row_stats(S, ai * HALF + wr * 64 + m * 16 + fr, mean, rstd);
                bf16_t* rowp = p0 + (size_t)(ai * HALF + m * 16) * ldc;
#pragma unroll
                for (int bj = 0; bj < 2; ++bj) { const int col = colt + bj * HALF;
                    const f32x4 c0 = *(const f32x4*)(cs + col), c1 = *(const f32x4*)(cs + col + 4), b0 = *(const f32x4*)(bw + col), b1 = *(const f32x4*)(bw + col + 4);
                    const f32x4 v0 = (acc[ai][bj][m][0] - c0 * mean) * rstd + b0, v1 = (acc[ai][bj][m][1] - c1 * mean) * rstd + b1; u32x4 w;
                    w.x = cvt_pk_bf16(v0[0], v0[1]); w.y = cvt_pk_bf16(v0[2], v0[3]); w.z = cvt_pk_bf16(v1[0], v1[1]); w.w = cvt_pk_bf16(v1[2], v1[3]);
                    *(u32x4*)(rowp + bj * HALF) = w; } }
    }
};
template <int MODE> struct EpiRes {
    static constexpr bool PERM = true, AFTER_DRAIN = false;
    const float* X; bf16_t* Yb; const LAS f32x2* Sin; const float* g; const float* b; float* Sout;
    __device__ __forceinline__ void operator()(const Acc& acc, const Unit& u, int wr, int wc, int fr, int fq) const {
        const int col0 = u.pn * 256 + wc * 32 + 8 * fq;
#pragma unroll
        for (int ai = 0; ai < 2; ++ai)
#pragma unroll
            for (int m = 0; m < 4; ++m) { const int trow = ai * HALF + wr * 64 + m * 16 + fr, row = u.pm * 256 + trow; const size_t off = (size_t)row * DM + col0;
                float mean = 0.f, rstd = 1.f; if (MODE > 0) row_stats(Sin, trow, mean, rstd);
                f32x4 rv[2][2];
#pragma unroll
                for (int bj = 0; bj < 2; ++bj) { const int dc = bj * HALF;
                    if (MODE == 0) { rv[bj][0] = *(const f32x4*)(X + off + dc); rv[bj][1] = *(const f32x4*)(X + off + dc + 4); }
                    else { const u32x4 w = *(const u32x4*)(Yb + off + dc);
                        const f32x4 y0 = {__builtin_bit_cast(float, w.x << 16), __builtin_bit_cast(float, w.x & 0xffff0000u), __builtin_bit_cast(float, w.y << 16), __builtin_bit_cast(float, w.y & 0xffff0000u)};
                        const f32x4 y1 = {__builtin_bit_cast(float, w.z << 16), __builtin_bit_cast(float, w.z & 0xffff0000u), __builtin_bit_cast(float, w.w << 16), __builtin_bit_cast(float, w.w & 0xffff0000u)};
                        rv[bj][0] = (y0 - mean) * rstd * *(const f32x4*)(g + col0 + dc) + *(const f32x4*)(b + col0 + dc);
                        rv[bj][1] = (y1 - mean) * rstd * *(const f32x4*)(g + col0 + dc + 4) + *(const f32x4*)(b + col0 + dc + 4); } }
                float ps = 0.f, pq = 0.f;
#pragma unroll
                for (int bj = 0; bj < 2; ++bj) { const f32x4 y0 = rv[bj][0] * ALPHA + acc[ai][bj][m][0], y1 = rv[bj][1] * ALPHA + acc[ai][bj][m][1]; u32x4 w;
                    w.x = cvt_pk_bf16(y0[0], y0[1]); w.y = cvt_pk_bf16(y0[2], y0[3]); w.z = cvt_pk_bf16(y1[0], y1[1]); w.w = cvt_pk_bf16(y1[2], y1[3]);
                    *(u32x4*)(Yb + off + bj * HALF) = w;
                    if (MODE < 2) { ps += ((y0[0] + y0[1]) + (y0[2] + y0[3])) + ((y1[0] + y1[1]) + (y1[2] + y1[3]));
                        pq += ((y0[0] * y0[0] + y0[1] * y0[1]) + (y0[2] * y0[2] + y0[3] * y0[3])) + ((y1[0] * y1[0] + y1[1] * y1[1]) + (y1[2] * y1[2] + y1[3] * y1[3])); } }
                if (MODE < 2) { ps += __shfl_xor(ps, 16); ps += __shfl_xor(ps, 32); pq += __shfl_xor(pq, 16); pq += __shfl_xor(pq, 32);
                    if (fq == 0) *(f32x2*)(Sout + ((size_t)row * 32 + 4 * u.pn + wc) * 2) = (f32x2){ps, pq}; }
            }
    }
};
struct EpiSwiglu {
    static constexpr bool PERM = true, AFTER_DRAIN = false;
    bf16_t* F; const LAS f32x2* S; const float* cs; const float* bw;
    __device__ __forceinline__ void operator()(const Acc& acc, const Unit& u, int wr, int wc, int fr, int fq) const {
        bf16_t* p0 = F + (size_t)(u.pm * 256 + wr * 64 + fr) * D_FF + u.pn * 128 + wc * 32 + 8 * fq;
        const int colt = u.pn * 256 + wc * 32 + 8 * fq;
        f32x4 cg[2], cu[2], bg[2], bu[2];
#pragma unroll
        for (int n = 0; n < 2; ++n) { cg[n] = *(const f32x4*)(cs + colt + 4 * n); cu[n] = *(const f32x4*)(cs + colt + HALF + 4 * n); bg[n] = *(const f32x4*)(bw + colt + 4 * n); bu[n] = *(const f32x4*)(bw + colt + HALF + 4 * n); }
#pragma unroll
        for (int ai = 0; ai < 2; ++ai)
#pragma unroll
            for (int m = 0; m < 4; ++m) { float mean, rstd; row_stats(S, ai * HALF + wr * 64 + m * 16 + fr, mean, rstd); float o[8];
#pragma unroll
                for (int n = 0; n < 2; ++n) { const f32x4 gv = (acc[ai][0][m][n] - cg[n] * mean) * rstd + bg[n], uv = (acc[ai][1][m][n] - cu[n] * mean) * rstd + bu[n];
#pragma unroll
                    for (int j = 0; j < 4; ++j) o[n * 4 + j] = gv[j] * __builtin_amdgcn_rcpf(1.0f + fexp2(-gv[j] * LOG2E)) * uv[j]; }
                u32x4 w; w.x = cvt_pk_bf16(o[0], o[1]); w.y = cvt_pk_bf16(o[2], o[3]); w.z = cvt_pk_bf16(o[4], o[5]); w.w = cvt_pk_bf16(o[6], o[7]);
                *(u32x4*)(p0 + (size_t)(ai * HALF + m * 16) * D_FF) = w; }
    }
};
struct EpiSoftmax {
    static constexpr bool PERM = true, AFTER_DRAIN = true;
    bf16_t* P;
    __device__ __forceinline__ void fused(Acc& acc, const Unit& u, int wr, int wc, int fr, int fq, LAS unsigned char* lds, int wid, int lane) const {
        const float c = 0.04419417382415922f * LOG2E;
        LAS f32x2* T = (LAS f32x2*)lds;
        float mw[2][4];
#pragma unroll
        for (int ai = 0; ai < 2; ++ai)
#pragma unroll
            for (int m = 0; m < 4; ++m) {
                float mx = -INFINITY;
#pragma unroll
                for (int bj = 0; bj < 2; ++bj)
#pragma unroll
                    for (int n = 0; n < 2; ++n) { const f32x4 x = acc[ai][bj][m][n]; mx = fmaxf(mx, fmaxf(fmaxf(x[0], x[1]), fmaxf(x[2], x[3]))); }
                mx = fmaxf(mx, __shfl_xor(mx, 16)); mx = fmaxf(mx, __shfl_xor(mx, 32));
                float s = 0.f;
#pragma unroll
                for (int bj = 0; bj < 2; ++bj)
#pragma unroll
                    for (int n = 0; n < 2; ++n) { f32x4 x = acc[ai][bj][m][n];
#pragma unroll
                        for (int j = 0; j < 4; ++j) { x[j] = fexp2((x[j] - mx) * c); s += x[j]; }
                        acc[ai][bj][m][n] = x; }
                s += __shfl_xor(s, 16); s += __shfl_xor(s, 32);
                mw[ai][m] = mx;
                if (fq == 0) T[(ai * HALF + wr * 64 + m * 16 + fr) * 4 + wc] = (f32x2){mx, s};
            }
        LDS_WAIT(); __builtin_amdgcn_s_barrier(); asm volatile("" ::: "memory");
        bf16_t* p0 = P + ((size_t)u.z * SEQ + u.pm * 256 + wr * 64 + fr) * MEML + wc * 32 + 8 * fq;
#pragma unroll
        for (int ai = 0; ai < 2; ++ai)
#pragma unroll
            for (int m = 0; m < 4; ++m) { const int row = ai * HALF + wr * 64 + m * 16 + fr;
                const f32x2 t0 = T[row * 4 + 0], t1 = T[row * 4 + 1], t2 = T[row * 4 + 2], t3 = T[row * 4 + 3];
                const float M = fmaxf(fmaxf(t0.x, t1.x), fmaxf(t2.x, t3.x));
                const float tot = t0.y * fexp2((t0.x - M) * c) + t1.y * fexp2((t1.x - M) * c) + t2.y * fexp2((t2.x - M) * c) + t3.y * fexp2((t3.x - M) * c);
                const float f = fexp2((mw[ai][m] - M) * c) / tot;
                bf16_t* rowp = p0 + (size_t)(ai * HALF + m * 16) * MEML;
#pragma unroll
                for (int bj = 0; bj < 2; ++bj) { const f32x4 v0 = acc[ai][bj][m][0] * f, v1 = acc[ai][bj][m][1] * f; u32x4 w;
                    w.x = cvt_pk_bf16(v0[0], v0[1]); w.y = cvt_pk_bf16(v0[2], v0[3]); w.z = cvt_pk_bf16(v1[0], v1[1]); w.w = cvt_pk_bf16(v1[2], v1[3]);
                    *(u32x4*)(rowp + bj * HALF) = w; } }
    }
};

template <class Epi, class Sched, bool ALIGN_EPI>
__device__ __forceinline__ void gemm_phase(LAS unsigned char* lds, const int lda, const int ldb, const int K, const Sched& S, const Epi& E) {
    const int tid = threadIdx.x, wid = __builtin_amdgcn_readfirstlane(tid >> 6), lane = tid & 63, wr = wid >> 2, wc = wid & 3, fr = lane & 15, fq = lane >> 4;
    const int nt = K / BK;
    unsigned voffA[2], voffB[2];
#pragma unroll
    for (int i = 0; i < 2; ++i) { int R, C; stage_rc(tid * 16 + i * 8192, R, C); const int Rb = Epi::PERM ? ((R & ~31) + perm32(R & 31)) : R;
        voffA[i] = (unsigned)(R * lda + C) * 2u; voffB[i] = (unsigned)(Rb * ldb + C) * 2u; }
    const size_t kstep = (size_t)(BK * 2);
    const size_t hsA = (size_t)HALF * lda * 2, hsB = (size_t)HALF * ldb * 2;
    const unsigned ldsw = (unsigned)wid * 1024u;
    const int aoff = lds_byte(wr * 64 + fr, fq * 8), boff = lds_byte(wc * 32 + fr, fq * 8);
#define PG8_SA(b, h) (((b) * 2 + (h)) * HTB)
#define PG8_SB(b, h) ((4 + (b) * 2 + (h)) * HTB)
#define PG8_STAGE(bufoff, gbase, voff) do { _Pragma("unroll") for (int _i = 0; _i < 2; ++_i) \
        __builtin_amdgcn_global_load_lds((const unsigned*)((const char*)(gbase) + (voff)[_i]), (LAS unsigned*)(lds + (bufoff) + ldsw + _i * 8192), 16, 0, 0); } while (0)
#define PG8_LDA(dst, b, h) do { _Pragma("unroll") for (int m = 0; m < 4; ++m) _Pragma("unroll") for (int k = 0; k < 2; ++k) dst[m][k] = *(const LAS bf16x8*)(lds + PG8_SA(b, h) + aoff + m * 2048 + k * 1024); } while (0)
#define PG8_LDB(dst, b, h) do { _Pragma("unroll") for (int n = 0; n < 2; ++n) _Pragma("unroll") for (int k = 0; k < 2; ++k) dst[n][k] = *(const LAS bf16x8*)(lds + PG8_SB(b, h) + boff + n * 2048 + k * 1024); } while (0)
#define PG8_MMA(ai, bj, At, Bt) do { __builtin_amdgcn_s_setprio(1); _Pragma("unroll") for (int m = 0; m < 4; ++m) _Pragma("unroll") for (int n = 0; n < 2; ++n) _Pragma("unroll") for (int k = 0; k < 2; ++k) \
        acc[ai][bj][m][n] = __builtin_amdgcn_mfma_f32_16x16x32_bf16(Bt[n][k], At[m][k], acc[ai][bj][m][n], 0, 0, 0); __builtin_amdgcn_s_setprio(0); } while (0)
#define PG8_WAIT_V(n) asm volatile("s_waitcnt vmcnt(" #n ")" ::: "memory")
#define PG8_WAIT_L(n) asm volatile("s_waitcnt lgkmcnt(" #n ")" ::: "memory")
#define PG8_BAR __builtin_amdgcn_s_barrier()
#define PG8_SCHED __builtin_amdgcn_sched_barrier(0)
    Unit cur, nxt; int ui = 0;
    if (!S.next(0, cur)) return;
    Acc acc;
#pragma unroll
    for (int a = 0; a < 2; ++a)
#pragma unroll
        for (int b = 0; b < 2; ++b)
#pragma unroll
            for (int m = 0; m < 4; ++m)
#pragma unroll
                for (int n = 0; n < 2; ++n) acc[a][b][m][n] = (f32x4){0.f, 0.f, 0.f, 0.f};
    bf16x8 At[4][2], B0[2][2], B1[2][2];
    const char* cA = S.pa(cur); const char* cB = S.pb(cur);
    PG8_STAGE(PG8_SB(0, 0), cB, voffB); PG8_STAGE(PG8_SB(0, 1), cB + hsB, voffB); PG8_STAGE(PG8_SA(0, 0), cA, voffA); PG8_STAGE(PG8_SA(0, 1), cA + hsA, voffA);
    if (wr == 1) PG8_BAR;
    PG8_WAIT_V(2); PG8_BAR;
    PG8_STAGE(PG8_SB(1, 0), cB + kstep, voffB); PG8_STAGE(PG8_SA(1, 0), cA + kstep, voffA); PG8_STAGE(PG8_SB(1, 1), cB + hsB + kstep, voffB);
    PG8_WAIT_V(6); PG8_BAR;
    for (;;) {
        const bool has_next = S.next(ui + 1, nxt);
        const char* nA = has_next ? S.pa(nxt) : cA; const char* nB = has_next ? S.pb(nxt) : cB;
#pragma unroll 1
        for (int t = 0; t < nt; t += 2) {
            const bool last = (t == nt - 2);
            const char* a1 = cA + (size_t)(t + 1) * kstep;
            const char* a2 = last ? nA : cA + (size_t)(t + 2) * kstep; const char* b2 = last ? nB : cB + (size_t)(t + 2) * kstep;
            const char* a3 = a2 + kstep; const char* b3 = b2 + kstep;
            PG8_LDB(B0, 0, 0); PG8_LDB(B1, 0, 1); PG8_SCHED; PG8_LDA(At, 0, 0); PG8_STAGE(PG8_SA(1, 1), a1 + hsA, voffA);
            PG8_WAIT_V(8); PG8_WAIT_L(0); PG8_BAR; PG8_MMA(0, 0, At, B0); PG8_MMA(0, 1, At, B1); PG8_BAR; PG8_SCHED;
            PG8_LDA(At, 0, 1); PG8_STAGE(PG8_SB(0, 0), b2, voffB); PG8_STAGE(PG8_SB(0, 1), b2 + hsB, voffB); PG8_STAGE(PG8_SA(0, 0), a2, voffA);
            PG8_WAIT_V(8); PG8_WAIT_L(0); PG8_BAR; PG8_MMA(1, 0, At, B0); PG8_MMA(1, 1, At, B1); PG8_BAR; PG8_SCHED;
            PG8_LDB(B0, 1, 0); PG8_LDB(B1, 1, 1); PG8_SCHED; PG8_LDA(At, 1, 0); PG8_STAGE(PG8_SA(0, 1), a2 + hsA, voffA);
            PG8_WAIT_V(8); PG8_WAIT_L(0); PG8_BAR; PG8_MMA(0, 0, At, B0); PG8_MMA(0, 1, At, B1); PG8_BAR; PG8_SCHED;
            PG8_LDA(At, 1, 1); PG8_STAGE(PG8_SB(1, 0), b3, voffB); PG8_STAGE(PG8_SB(1, 1), b3 + hsB, voffB); PG8_STAGE(PG8_SA(1, 0), a3, voffA);
            PG8_WAIT_V(8); PG8_WAIT_L(0); PG8_BAR; PG8_MMA(1, 0, At, B0); PG8_MMA(1, 1, At, B1); PG8_BAR; PG8_SCHED;
        }
        if constexpr (ALIGN_EPI) { if (wr == 0) PG8_BAR; }
        if constexpr (!Epi::AFTER_DRAIN) { E(acc, cur, wr, wc, fr, fq); }
        if (!has_next) break;
#pragma unroll
        for (int a = 0; a < 2; ++a)
#pragma unroll
            for (int b = 0; b < 2; ++b)
#pragma unroll
                for (int m = 0; m < 4; ++m)
#pragma unroll
                    for (int n = 0; n < 2; ++n) acc[a][b][m][n] = (f32x4){0.f, 0.f, 0.f, 0.f};
        cur = nxt; cA = nA; cB = nB; ++ui;
        if constexpr (ALIGN_EPI) { if (wr == 1) PG8_BAR; }
    }
    PG8_WAIT_V(0);
    if constexpr (!ALIGN_EPI) { if (wr == 0) PG8_BAR; }
    PG8_BAR;
    if constexpr (Epi::AFTER_DRAIN) { E.fused(acc, cur, wr, wc, fr, fq, lds, wid, lane); }
#undef PG8_SA
#undef PG8_SB
#undef PG8_STAGE
#undef PG8_LDA
#undef PG8_LDB
#undef PG8_MMA
#undef PG8_WAIT_V
#undef PG8_WAIT_L
#undef PG8_BAR
#undef PG8_SCHED
}
}

__device__ __forceinline__ void transpose_item(const float* W, int N, bf16_t* WT, int ldt, int k0, int n0, int dest_row0, LAS float* scr, int lane) {
#pragma unroll 8
    for (int i = 0; i < 32; ++i) { const int kk = 2 * i + (lane >> 5); scr[kk * 33 + (lane & 31)] = W[(size_t)(k0 + kk) * N + n0 + (lane & 31)]; }
    LDS_WAIT(); asm volatile("" ::: "memory");
    const int c = lane & 7;
#pragma unroll
    for (int j = 0; j < 4; ++j) { const int n = (lane >> 3) + 8 * j; const LAS float* s = scr + (8 * c) * 33 + n;
        u32x4 o; o.x = cvt_pk_bf16(s[0 * 33], s[1 * 33]); o.y = cvt_pk_bf16(s[2 * 33], s[3 * 33]); o.z = cvt_pk_bf16(s[4 * 33], s[5 * 33]); o.w = cvt_pk_bf16(s[6 * 33], s[7 * 33]);
        *(u32x4*)(WT + (size_t)(dest_row0 + n) * ldt + k0 + 8 * c) = o; }
    LDS_WAIT(); asm volatile("" ::: "memory");
}

__device__ __forceinline__ void transpose_item_ln(const float* W, int N, bf16_t* WT, int ldt, int k0, int n0, int dest_row0, LAS float* scr, int lane, const float* g, const float* b, float* csp_out, float* bwp_out) {
    float csp = 0.f, bwp = 0.f;
#pragma unroll 8
    for (int i = 0; i < 32; ++i) { const int kk = 2 * i + (lane >> 5); const float w = W[(size_t)(k0 + kk) * N + n0 + (lane & 31)], wg = w * g[k0 + kk];
        scr[kk * 33 + (lane & 31)] = wg; csp += wg; bwp += w * b[k0 + kk]; }
    csp += __shfl_xor(csp, 32); bwp += __shfl_xor(bwp, 32);
    if (lane < 32) { csp_out[lane] = csp; bwp_out[lane] = bwp; }
    LDS_WAIT(); asm volatile("" ::: "memory");
    const int c = lane & 7;
#pragma unroll
    for (int j = 0; j < 4; ++j) { const int n = (lane >> 3) + 8 * j; const LAS float* s = scr + (8 * c) * 33 + n;
        u32x4 o; o.x = cvt_pk_bf16(s[0 * 33], s[1 * 33]); o.y = cvt_pk_bf16(s[2 * 33], s[3 * 33]); o.z = cvt_pk_bf16(s[4 * 33], s[5 * 33]); o.w = cvt_pk_bf16(s[6 * 33], s[7 * 33]);
        *(u32x4*)(WT + (size_t)(dest_row0 + n) * ldt + k0 + 8 * c) = o; }
    LDS_WAIT(); asm volatile("" ::: "memory");
}

__device__ __forceinline__ int crow(int r, int hi) { return (r & 3) + 8 * (r >> 2) + 4 * hi; }

__device__ __forceinline__ void load_k(bf16x8 (&kf)[4], const bf16_t* blk) {
#pragma unroll
    for (int s = 0; s < 4; ++s) kf[s] = *(const bf16x8*)(blk + 512 * s);
}
__device__ __forceinline__ void load_v(bf16x8 (&vf)[2][2], const bf16_t* blk) {
#pragma unroll
    for (int db = 0; db < 2; ++db)
#pragma unroll
        for (int s = 0; s < 2; ++s) vf[db][s] = *(const bf16x8*)(blk + 512 * (db * 2 + s));
}
__device__ __forceinline__ bf16x8 pack8(const float* p) {
    const unsigned a = cvt_pk_bf16(p[0], p[1]), b = cvt_pk_bf16(p[2], p[3]), c = cvt_pk_bf16(p[4], p[5]), d = cvt_pk_bf16(p[6], p[7]);
    u32x4 w = {a, b, c, d}; return __builtin_bit_cast(bf16x8, w);
}
__device__ __forceinline__ void rms_store(const f32x16& o0, const f32x16& o1, const float* g, bf16_t* Obase  , int lane, LAS unsigned char* stg) {
    const int q = lane & 31, hi = lane >> 5;
    float ss = 0.f;
#pragma unroll
    for (int r = 0; r < 16; ++r) ss += o0[r] * o0[r] + o1[r] * o1[r];
    ss += __shfl_xor(ss, 32);
    const float rs = 1.0f / sqrtf(ss * (1.0f / 64.0f) + RMS_EPS);
#pragma unroll
    for (int db = 0; db < 2; ++db)
#pragma unroll
        for (int i = 0; i < 4; ++i) { const int d = 32 * db + 8 * i + 4 * hi; const f32x4 gg = *(const f32x4*)(g + d);
            const float a0 = (db ? o1[4 * i + 0] : o0[4 * i + 0]) * rs * gg[0], a1 = (db ? o1[4 * i + 1] : o0[4 * i + 1]) * rs * gg[1];
            const float a2 = (db ? o1[4 * i + 2] : o0[4 * i + 2]) * rs * gg[2], a3 = (db ? o1[4 * i + 3] : o0[4 * i + 3]) * rs * gg[3];
            u32x2 w; w.x = cvt_pk_bf16(a0, a1); w.y = cvt_pk_bf16(a2, a3); *(LAS u32x2*)(stg + q * 144 + d * 2) = w; }
    LDS_WAIT(); asm volatile("" ::: "memory");
#pragma unroll
    for (int k = 0; k < 4; ++k) { const int row = (lane >> 3) + 8 * k, ch = lane & 7;
        const u32x4 w = *(const LAS u32x4*)(stg + row * 144 + ch * 16);
        *(u32x4*)(Obase + (size_t)row * DM + ch * 8) = w; }
    LDS_WAIT(); asm volatile("" ::: "memory");
}

template <bool DIAG>
__device__ __forceinline__ void sb_block(const f32x16& st, float& R, int lim  , int hi, bf16x8& pb0, bf16x8& pb1) {
    float L[16], lb[16];
#pragma unroll
    for (int r = 0; r < 16; ++r) {
        const float z2 = st[r] * (0.125f * LOG2E);
        const float e = fexp2(-fabsf(z2));
        const float l2 = flog2(1.0f + e);
        float b = fminf(z2, 0.f) - l2;
        float l1 = b - z2;
        if (DIAG) { const bool valid = crow(r, hi) < lim; l1 = valid ? l1 : 0.f; b = valid ? b : -INFINITY; }
        L[r] = l1; lb[r] = b;
    }
    float gs[4], pg[4];
#pragma unroll
    for (int i = 0; i < 4; ++i) { gs[i] = (L[4 * i] + L[4 * i + 1]) + (L[4 * i + 2] + L[4 * i + 3]); pg[i] = __shfl_xor(gs[i], 32); }
    float p[16];
    float suf = R;
#pragma unroll
    for (int i = 3; i >= 0; --i) {
        float off = suf + (hi == 0 ? pg[i] : 0.f);
        p[4 * i + 3] = fexp2(lb[4 * i + 3] + off); off += L[4 * i + 3];
        p[4 * i + 2] = fexp2(lb[4 * i + 2] + off); off += L[4 * i + 2];
        p[4 * i + 1] = fexp2(lb[4 * i + 1] + off); off += L[4 * i + 1];
        p[4 * i + 0] = fexp2(lb[4 * i + 0] + off);
        suf += gs[i] + pg[i];
    }
    R = suf;
    pb0 = pack8(p); pb1 = pack8(p + 8);
}

__device__ __forceinline__ void sb_wave(const bf16_t* QK, const bf16_t* VT, bf16_t* O, const float* g_sb, int b, int h, int t0, int lane, LAS unsigned char* stg) {
    const int q = lane & 31, hi = lane >> 5;
    const size_t rowq = (size_t)(b * SEQ + t0 + q);
    const bf16_t* qblk = QK + ((size_t)(b * 52 + 20 + h) * 64) * 2048 + lane * 8;
    const bf16_t* kblk = QK + ((size_t)(b * 52 + 36 + h) * 64) * 2048 + lane * 8;
    const bf16_t* vblk = VT + ((size_t)(b * 20 + 4 + h) * 64) * 2048 + lane * 8;
    bf16x8 qf[4]; load_k(qf, qblk + (size_t)(t0 >> 5) * 2048);
    f32x16 o0, o1;
#pragma unroll
    for (int r = 0; r < 16; ++r) { o0[r] = 0.f; o1[r] = 0.f; }
    float R = 0.f;
    bf16x8 kf[4], kn[4], vf[2][2], pb0, pb1;
    load_k(kf, kblk + (size_t)(t0 >> 5) * 2048);
    for (int k0 = t0; k0 >= 0; k0 -= 32) {
        load_v(vf, vblk + (size_t)(k0 >> 5) * 2048);
        if (k0 >= 32) load_k(kn, kblk + (size_t)((k0 >> 5) - 1) * 2048);
        f32x16 st;
#pragma unroll
        for (int r = 0; r < 16; ++r) st[r] = 0.f;
#pragma unroll
        for (int s = 0; s < 4; ++s) st = __builtin_amdgcn_mfma_f32_32x32x16_bf16(kf[s], qf[s], st, 0, 0, 0);
        if (k0 == t0) sb_block<true>(st, R, q, hi, pb0, pb1); else sb_block<false>(st, R, 64, hi, pb0, pb1);
        o0 = __builtin_amdgcn_mfma_f32_32x32x16_bf16(vf[0][0], pb0, o0, 0, 0, 0);
        o0 = __builtin_amdgcn_mfma_f32_32x32x16_bf16(vf[0][1], pb1, o0, 0, 0, 0);
        o1 = __builtin_amdgcn_mfma_f32_32x32x16_bf16(vf[1][0], pb0, o1, 0, 0, 0);
        o1 = __builtin_amdgcn_mfma_f32_32x32x16_bf16(vf[1][1], pb1, o1, 0, 0, 0);
        if (__all(R < -150.0f)) break;
#pragma unroll
        for (int s = 0; s < 4; ++s) kf[s] = kn[s];
    }
    rms_store(o0, o1, g_sb + h * 64, O + (size_t)(b * SEQ + t0) * DM + 1024 + h * 64, lane, stg);
}

__device__ __forceinline__ void swa_wave(const bf16_t* QK, const bf16_t* VT, bf16_t* O, const float* g_swa, const float* sinks, int b, int hq, int t0, int lane, LAS unsigned char* stg) {
    const int q = lane & 31, hi = lane >> 5, kvh = hq >> 2;
    const size_t rowq = (size_t)(b * SEQ + t0 + q);
    const bf16_t* qblk = QK + ((size_t)(b * 52 + hq) * 64) * 2048 + lane * 8;
    const bf16_t* kblk = QK + ((size_t)(b * 52 + 16 + kvh) * 64) * 2048 + lane * 8;
    const bf16_t* vblk = VT + ((size_t)(b * 20 + kvh) * 64) * 2048 + lane * 8;
    bf16x8 qf[4]; load_k(qf, qblk + (size_t)(t0 >> 5) * 2048);
    const float slope2 = fexp2(-0.5f * (float)(hq + 1)) * LOG2E;
    const float sink2 = sinks[hq] * LOG2E;
    f32x16 st[5];
#pragma unroll
    for (int jb = 0; jb < 5; ++jb) {
        const int k0 = t0 - 128 + 32 * jb;
#pragma unroll
        for (int r = 0; r < 16; ++r) st[jb][r] = 0.f;
        if (k0 >= 0) { bf16x8 kf[4]; load_k(kf, kblk + (size_t)(k0 >> 5) * 2048);
#pragma unroll
            for (int s = 0; s < 4; ++s) st[jb] = __builtin_amdgcn_mfma_f32_32x32x16_bf16(kf[s], qf[s], st[jb], 0, 0, 0); }
    }
    float mx = sink2;
#pragma unroll
    for (int jb = 0; jb < 5; ++jb) {
        const int k0 = t0 - 128 + 32 * jb;
#pragma unroll
        for (int r = 0; r < 16; ++r) { const int dist = q + 128 - 32 * jb - crow(r, hi);
            const bool valid = (k0 >= 0) && (dist >= 0) && (dist < 128);
            const float sc = valid ? (st[jb][r] * (0.125f * LOG2E) - slope2 * (float)dist) : -INFINITY;
            st[jb][r] = sc; mx = fmaxf(mx, sc); }
    }
    mx = fmaxf(mx, __shfl_xor(mx, 32));
    float sum = 0.f;
#pragma unroll
    for (int jb = 0; jb < 5; ++jb)
#pragma unroll
        for (int r = 0; r < 16; ++r) { const float p = fexp2(st[jb][r] - mx); st[jb][r] = p; sum += p; }
    sum += __shfl_xor(sum, 32);
    const float inv = 1.0f / (sum + fexp2(sink2 - mx));
    f32x16 o0, o1;
#pragma unroll
    for (int r = 0; r < 16; ++r) { o0[r] = 0.f; o1[r] = 0.f; }
#pragma unroll
    for (int jb = 0; jb < 5; ++jb) {
        const int k0 = t0 - 128 + 32 * jb;
        if (k0 >= 0) { bf16x8 vf[2][2]; load_v(vf, vblk + (size_t)(k0 >> 5) * 2048);
            float p[16];
#pragma unroll
            for (int r = 0; r < 16; ++r) p[r] = st[jb][r] * inv;
            const bf16x8 pb0 = pack8(p), pb1 = pack8(p + 8);
            o0 = __builtin_amdgcn_mfma_f32_32x32x16_bf16(vf[0][0], pb0, o0, 0, 0, 0);
            o0 = __builtin_amdgcn_mfma_f32_32x32x16_bf16(vf[0][1], pb1, o0, 0, 0, 0);
            o1 = __builtin_amdgcn_mfma_f32_32x32x16_bf16(vf[1][0], pb0, o1, 0, 0, 0);
            o1 = __builtin_amdgcn_mfma_f32_32x32x16_bf16(vf[1][1], pb1, o1, 0, 0, 0); }
    }
    rms_store(o0, o1, g_swa + hq * 64, O + (size_t)(b * SEQ + t0) * DM + hq * 64, lane, stg);
}

__device__ __forceinline__ f32x4 bf4lo(const u32x4& w) { return (f32x4){__builtin_bit_cast(float, w.x << 16), __builtin_bit_cast(float, w.x & 0xffff0000u), __builtin_bit_cast(float, w.y << 16), __builtin_bit_cast(float, w.y & 0xffff0000u)}; }
__device__ __forceinline__ f32x4 bf4hi(const u32x4& w) { return (f32x4){__builtin_bit_cast(float, w.z << 16), __builtin_bit_cast(float, w.z & 0xffff0000u), __builtin_bit_cast(float, w.w << 16), __builtin_bit_cast(float, w.w & 0xffff0000u)}; }
__device__ __forceinline__ void ln_rows(const bf16_t* Y, const float* g, const float* bta, float* Hf, bf16_t* Hb, int gw, int ngw, int lane) {
    for (int row = gw; row < MTOK; row += ngw) {
        const u32x4* yr = (const u32x4*)(Y + (size_t)row * DM) + lane;
        f32x4 v[8]; float s = 0.f;
#pragma unroll
        for (int j = 0; j < 4; ++j) { const u32x4 w = yr[64 * j]; v[2 * j] = bf4lo(w); v[2 * j + 1] = bf4hi(w); }
#pragma unroll
        for (int j = 0; j < 8; ++j) s += (v[j][0] + v[j][1]) + (v[j][2] + v[j][3]);
        const float mean = wave_sum(s) * (1.0f / DM); float s2 = 0.f;
#pragma unroll
        for (int j = 0; j < 8; ++j) { v[j] = v[j] - mean; s2 += (v[j][0] * v[j][0] + v[j][1] * v[j][1]) + (v[j][2] * v[j][2] + v[j][3] * v[j][3]); }
        const float rstd = 1.0f / sqrtf(wave_sum(s2) * (1.0f / DM) + LN_EPS);
#pragma unroll
        for (int j = 0; j < 4; ++j) { const int e = 8 * (lane + 64 * j);
            const f32x4 g0 = *(const f32x4*)(g + e), g1 = *(const f32x4*)(g + e + 4), b0 = *(const f32x4*)(bta + e), b1 = *(const f32x4*)(bta + e + 4);
            const f32x4 o0 = v[2 * j] * rstd * g0 + b0, o1 = v[2 * j + 1] * rstd * g1 + b1;
            if (Hf) { *(f32x4*)(Hf + (size_t)row * DM + e) = o0; *(f32x4*)(Hf + (size_t)row * DM + e + 4) = o1; }
            if (Hb) { u32x4 w; w.x = cvt_pk_bf16(o0[0], o0[1]); w.y = cvt_pk_bf16(o0[2], o0[3]); w.z = cvt_pk_bf16(o1[0], o1[1]); w.w = cvt_pk_bf16(o1[2], o1[3]); *(u32x4*)(Hb + (size_t)row * DM + e) = w; } }
    }
}

#define XB_TMO      128
#define XB_XCNT(j)  (256  + 64 * (j))
#define XB_XSUB(j)  (1280 + 64 * (j))
#define XB_XGEN(j)  (2304 + 64 * (j))
#define XB_TOP      3328
#define XB_TOPGEN   3392
#define XCD_BAR_WORDS 3456
#define XB_SPIN_CAP (1u << 18)

__device__ __forceinline__ unsigned xb_ld(unsigned* p)              { return __hip_atomic_load(p, __ATOMIC_RELAXED, __HIP_MEMORY_SCOPE_AGENT); }
__device__ __forceinline__ unsigned xb_add(unsigned* p, unsigned v) { return __hip_atomic_fetch_add(p, v, __ATOMIC_RELAXED, __HIP_MEMORY_SCOPE_AGENT); }
__device__ __forceinline__ unsigned xb_xcc_id() { return (unsigned)__builtin_amdgcn_s_getreg((3 << 11) | 20) & 0xFu; }
#define XB_SPIN(cond, bar) do { unsigned _sp = 0; while (cond) { __builtin_amdgcn_s_sleep(1); \
    if ((++_sp & 255u) == 0u) { if (xb_ld(&(bar)[XB_TMO])) break; if (_sp > XB_SPIN_CAP) { atomicAdd(&(bar)[XB_TMO], 1u); break; } } } } while (0)

struct XcdBarrier {
    unsigned* bar; unsigned x;
    volatile LAS unsigned* st;
};

__device__ __forceinline__ XcdBarrier xcd_barrier_post(unsigned* bar, volatile LAS unsigned* st) {
    XcdBarrier b; b.bar = bar; b.x = xb_xcc_id(); b.st = st;
    if (threadIdx.x == 0) (void)xb_add(&bar[XB_XCNT(b.x)], 1u);
    return b;
}
__device__ __forceinline__ void xcd_barrier_complete(unsigned* bar, unsigned x, unsigned& nloc, unsigned& nx) {
    const unsigned G = gridDim.x * gridDim.y * gridDim.z;
    unsigned sum, cnt, mine, sp = 0u;
    for (;;) {
        sum = 0u; cnt = 0u; mine = 0u;
#pragma unroll
        for (unsigned j = 0; j < 16; ++j) { const unsigned c = xb_ld(&bar[XB_XCNT(j)]); sum += c; cnt += (c > 0u) ? 1u : 0u; mine = (j == x) ? c : mine; }
        if (sum == G) break;
        __builtin_amdgcn_s_sleep(1);
        if ((++sp & 255u) == 0u) { if (xb_ld(&bar[XB_TMO])) break; if (sp > XB_SPIN_CAP) { atomicAdd(&bar[XB_TMO], 1u); break; } }
    }
    nloc = mine > 0u ? mine : 1u; nx = cnt > 0u ? cnt : 1u;
}

__device__ __forceinline__ void xcd_barrier(const XcdBarrier& b) {
    asm volatile("s_waitcnt vmcnt(0)" ::: "memory");
    __syncthreads();
    if (threadIdx.x == 0) {
        unsigned* bar = b.bar;
        __builtin_amdgcn_s_waitcnt(0);
        unsigned nloc = b.st[0], nx = b.st[1];
        if (nloc == 0u) { xcd_barrier_complete(bar, b.x, nloc, nx); b.st[0] = nloc; b.st[1] = nx; }
        const unsigned old = xb_add(&bar[XB_XSUB(b.x)], 1u);
        const unsigned gen = old / nloc;
        if (old + 1u == (gen + 1u) * nloc) {
            __builtin_amdgcn_fence(__ATOMIC_RELEASE, "agent");
            asm volatile("s_waitcnt vmcnt(0)" ::: "memory");
            const unsigned og = xb_add(&bar[XB_TOP], 1u);
            const unsigned tg = og / nx;
            if (og + 1u == (tg + 1u) * nx) xb_add(&bar[XB_TOPGEN], 1u);
            else XB_SPIN(xb_ld(&bar[XB_TOPGEN]) == tg, bar);
            __builtin_amdgcn_fence(__ATOMIC_ACQUIRE, "agent");
            xb_add(&bar[XB_XGEN(b.x)], 1u);
            asm volatile("s_waitcnt vmcnt(0)" ::: "memory");
        } else {
            XB_SPIN(xb_ld(&bar[XB_XGEN(b.x)]) == gen, bar);
            __builtin_amdgcn_fence(__ATOMIC_ACQUIRE, "agent");
            asm volatile("s_waitcnt vmcnt(0)" ::: "memory");
        }
    }
    __syncthreads();
}


__device__ __forceinline__ void stats_table(const float* Sp, int pm, LAS f32x2* tab, int tid) {
    const int row = tid >> 1, half = tid & 1;
    const f32x4* p = (const f32x4*)(Sp + ((size_t)(pm * 256 + row) * 32 + half * 16) * 2);
    float s = 0.f, q = 0.f;
#pragma unroll
    for (int j = 0; j < 8; ++j) { const f32x4 v = p[j]; s += v[0] + v[2]; q += v[1] + v[3]; }
    s += __shfl_xor(s, 1); q += __shfl_xor(q, 1);
    const float mean = s * (1.0f / DM), var = q * (1.0f / DM) - mean * mean;
    if (half == 0) tab[row] = (f32x2){mean, 1.0f / sqrtf(var + LN_EPS)};
    __syncthreads();
}

struct Args { const float* in[18]; float* out; unsigned char* ws; int ph_lo, ph_hi; };
constexpr int LDS_BYTES = 147456;

__global__ void __launch_bounds__(512, 2) hymba_fwd(Args a) {
    extern __shared__ __attribute__((aligned(16))) unsigned char lds_raw[];
    LAS unsigned char* lds = (LAS unsigned char*)lds_raw;
    cg::grid_group grid = cg::this_grid();
    const int tid = threadIdx.x, lane = tid & 63, wave = __builtin_amdgcn_readfirstlane(tid >> 6);
    const int G = gridDim.x, c = blockIdx.x;
    const int gw = c * 8 + wave, ngw = G * 8;
    unsigned char* ws = a.ws;
    const float *x = a.in[0], *mem = a.in[1], *w_in = a.in[2], *sinks = a.in[3], *g_swa = a.in[4], *g_sb = a.in[5], *w_o = a.in[6], *ln1_g = a.in[7], *ln1_b = a.in[8],
                *w_q_mem = a.in[9], *w_kv_mem = a.in[10], *w_o_mem = a.in[11], *ln2_g = a.in[12], *ln2_b = a.in[13], *w_gate_up = a.in[14], *w_down = a.in[15], *ln3_g = a.in[16], *ln3_b = a.in[17];
    bf16_t* ALL = (bf16_t*)(ws + WS_ALL);
    bf16_t* Ob = ALL;
    bf16_t* Hb = ALL;
    bf16_t *QK = (bf16_t*)(ws + WS_QK), *VT = (bf16_t*)(ws + WS_VT), *KM = (bf16_t*)(ws + WS_KM), *VMT = (bf16_t*)(ws + WS_VMT);
    bf16_t *WoT = (bf16_t*)(ws + WS_WO), *WqmT = (bf16_t*)(ws + WS_WQM), *WomT = (bf16_t*)(ws + WS_WOM), *WguT = (bf16_t*)(ws + WS_WGU), *WdT = (bf16_t*)(ws + WS_WD);
    bf16_t *Qm = (bf16_t*)(ws + WS_QM), *Pm = (bf16_t*)(ws + WS_P), *Oc = (bf16_t*)(ws + WS_OC), *Fb = (bf16_t*)(ws + WS_F);
    bf16_t* Yb = (bf16_t*)(ws + WS_Y);
    float *SP1 = (float*)(ws + WS_SP1), *SP2 = (float*)(ws + WS_SP2);
    float *csp = (float*)(ws + WS_CSP), *csf = (float*)(ws + WS_CSF);
    const float *cs1 = csf, *bw1 = csf + NCS, *cs2 = csf + 2048, *bw2 = csf + NCS + 2048;
    LAS f32x2* tab = (LAS f32x2*)(lds + 131072 + 1024);
    float* Hf = a.out;
    const int lo = a.ph_lo, hi_ = a.ph_hi;
    volatile LAS unsigned* xst = (volatile LAS unsigned*)(lds + 131072);
    if (tid == 0) { xst[0] = 0u; xst[1] = 0u; }
    __syncthreads();
    XcdBarrier xbar; xbar.bar = (unsigned*)(ws + WS_CTL); xbar.x = 0; xbar.st = xst;
    if (hi_ - lo > 1) { xbar = xcd_barrier_post((unsigned*)(ws + WS_CTL), xst);
        grid.sync(); }
#ifdef ONLY
#define IN(k) ((k) == ONLY && lo <= (k) && (k) < hi_)
#else
#define IN(k) (lo <= (k) && (k) < hi_)
#endif
#define SEAM(k) do { if (IN(k) && IN((k) + 1)) { xcd_barrier(xbar); } } while (0)
#ifndef REPEAT
#define REPEAT (-1)
#endif
#define REP(k) for (int rep_ = 0; rep_ < ((k) == REPEAT ? 2 : 1); ++rep_, ((k) == REPEAT ? grid.sync() : (void)0))

    if (IN(0)) REP(0) {
        LAS float* scr = (LAS float*)(lds + wave * 16384);
        constexpr int I0 = 32 * 144, I1 = 32 * 128, I2 = 32 * 64, I5 = 32 * 352, I6 = 88 * 64;
        constexpr int NIT = I0 + I1 + 3 * I2 + I5 + I6;
        for (int it = gw; it < NIT; it += ngw) {
            int r = it;
            if (r < I0) { const int kb = r / 144, nb = r % 144; transpose_item(w_in, D_IN, ALL, DM, 64 * kb, 32 * nb, 18432 + 32 * nb, scr, lane); continue; } r -= I0;
            if (r < I1) { const int kb = r / 128, nb = r % 128; transpose_item(w_kv_mem, 4096, ALL, DM, 64 * kb, 32 * nb, 23040 + 32 * nb, scr, lane); continue; } r -= I1;
            if (r < I2) { const int kb = r / 64, nb = r % 64; transpose_item(w_o, DM, WoT, DM, 64 * kb, 32 * nb, 32 * nb, scr, lane); continue; } r -= I2;
            if (r < I2) { const int kb = r / 64, nb = r % 64; transpose_item_ln(w_q_mem, DM, WqmT, DM, 64 * kb, 32 * nb, 32 * nb, scr, lane, ln1_g, ln1_b, csp + (size_t)(kb * 2) * NCS + 32 * nb, csp + (size_t)(kb * 2 + 1) * NCS + 32 * nb); continue; } r -= I2;
            if (r < I2) { const int kb = r / 64, nb = r % 64; transpose_item(w_o_mem, DM, WomT, DM, 64 * kb, 32 * nb, 32 * nb, scr, lane); continue; } r -= I2;
            if (r < I5) { const int kb = r / 352, nb = r % 352; const int n0 = 32 * nb, part = n0 >= D_FF ? 1 : 0, j = n0 - part * D_FF;
                const int dr = 256 * (j >> 7) + 128 * part + (j & 127); transpose_item_ln(w_gate_up, 2 * D_FF, WguT, DM, 64 * kb, n0, dr, scr, lane, ln2_g, ln2_b, csp + (size_t)(kb * 2) * NCS + 2048 + dr, csp + (size_t)(kb * 2 + 1) * NCS + 2048 + dr); continue; } r -= I5;
            { const int kb = r / 64, nb = r % 64; transpose_item(w_down, DM, WdT, D_FF, 64 * kb, 32 * nb, 32 * nb, scr, lane); }
        }
        const size_t nx8 = (size_t)MTOK * DM / 8, nm8 = (size_t)MROWS * DM / 8;
        for (size_t i = (size_t)c * 512 + tid; i < nx8 + nm8; i += (size_t)G * 512) {
            const float* src = i < nx8 ? x + i * 8 : mem + (i - nx8) * 8;
            const f32x4 v0 = *(const f32x4*)src, v1 = *(const f32x4*)(src + 4);
            u32x4 w; w.x = cvt_pk_bf16(v0[0], v0[1]); w.y = cvt_pk_bf16(v0[2], v0[3]); w.z = cvt_pk_bf16(v1[0], v1[1]); w.w = cvt_pk_bf16(v1[2], v1[3]);
            *(u32x4*)(ALL + i * 8) = w;
        }
    }
    SEAM(0);
    if (IN(1)) REP(1) {
        pg8::SchedP1 S{(const char*)ALL, G, c};
        pg8::EpiP1 E{QK, VT, KM, VMT};
        pg8::gemm_phase<pg8::EpiP1, pg8::SchedP1, true>(lds, DM, DM, DM, S, E);
    }
    SEAM(1);
    if (IN(2)) REP(2) {
        if (G == 256) {
            const int pair = c >> 1, b = pair >> 4, h = pair & 15;
#pragma unroll 1
            for (int j = 0; j < 4; ++j) {
                const int qb = (c & 1) ? (j == 0 ? 1 : (j == 1 ? 6 : (j == 2 ? 3 : 4))) : (j == 0 ? 0 : (j == 1 ? 7 : (j == 2 ? 2 : 5)));
                const int w = (j & 1) ? 7 - wave : wave;
                sb_wave(QK, VT, Ob, g_sb, b, h, 256 * qb + 32 * w, lane, lds + wave * 16384);
            }
        } else {
            for (int u = gw; u < NB * 16 * 64; u += ngw) sb_wave(QK, VT, Ob, g_sb, u >> 10, (u >> 6) & 15, 32 * (u & 63), lane, lds + wave * 16384);
        }
        for (int u = gw; u < NB * 16 * 64; u += ngw) swa_wave(QK, VT, Ob, g_swa, sinks, u >> 10, (u >> 6) & 15, 32 * (u & 63), lane, lds + wave * 16384);
    }
    SEAM(2);
    if (IN(3)) {
        for (int i = c * 512 + tid; i < 2 * NCS; i += G * 512) { float acc_ = 0.f;
#pragma unroll 8
            for (int kb = 0; kb < 32; ++kb) acc_ += csp[(size_t)kb * 2 * NCS + i];
            csf[i] = acc_; }
    }
    if (IN(3)) {
        pg8::SchedPlain S; S.init(Ob, DM, WoT, DM, MTOK, DM, G, c);
        pg8::EpiRes<0> E{x, Yb, nullptr, nullptr, nullptr, SP1};
        pg8::gemm_phase<pg8::EpiRes<0>, pg8::SchedPlain, true>(lds, DM, DM, DM, S, E);
    }
    SEAM(3);
    if (IN(5)) {
        pg8::SchedPlain S; S.init(Yb, DM, WqmT, DM, MTOK, DM, G, c);
        { pg8::Unit u0; int pm0 = 0; if (S.next(0, u0)) pm0 = u0.pm; stats_table(SP1, pm0, tab, tid); }
        pg8::EpiLnPlain E{Qm, DM, tab, cs1, bw1};
        pg8::gemm_phase<pg8::EpiLnPlain, pg8::SchedPlain, true>(lds, DM, DM, DM, S, E);
    }
    SEAM(5);
    if (IN(6)) {
        pg8::SchedQK S{(const char*)Qm, (const char*)KM, G, c};
        pg8::EpiSoftmax E{Pm};
        pg8::gemm_phase<pg8::EpiSoftmax, pg8::SchedQK, false>(lds, DM, DM, 512, S, E);
    }
    SEAM(6);
    if (IN(7)) {
        pg8::SchedPV S{(const char*)Pm, (const char*)VMT, G, c};
        pg8::EpiPV E{Oc};
        pg8::gemm_phase<pg8::EpiPV, pg8::SchedPV, true>(lds, MEML, MROWS, MEML, S, E);
    }
    SEAM(7);
    if (IN(8)) {
        pg8::SchedPlain S; S.init(Oc, DM, WomT, DM, MTOK, DM, G, c);
        { pg8::Unit u0; int pm0 = 0; if (S.next(0, u0)) pm0 = u0.pm; stats_table(SP1, pm0, tab, tid); }
        pg8::EpiRes<1> E{nullptr, Yb, tab, ln1_g, ln1_b, SP2};
        pg8::gemm_phase<pg8::EpiRes<1>, pg8::SchedPlain, true>(lds, DM, DM, DM, S, E);
    }
    SEAM(8);
    if (IN(10)) {
        pg8::SchedPlain S; S.init(Yb, DM, WguT, DM, MTOK, 2 * D_FF, G, c);
        { pg8::Unit u0; int pm0 = 0; if (S.next(0, u0)) pm0 = u0.pm; stats_table(SP2, pm0, tab, tid); }
        pg8::EpiSwiglu E{Fb, tab, cs2, bw2};
        pg8::gemm_phase<pg8::EpiSwiglu, pg8::SchedPlain, true>(lds, DM, DM, DM, S, E);
    }
    SEAM(10);
    if (IN(11)) {
        pg8::SchedPlain S; S.init(Fb, D_FF, WdT, D_FF, MTOK, DM, G, c);
        { pg8::Unit u0; int pm0 = 0; if (S.next(0, u0)) pm0 = u0.pm; stats_table(SP2, pm0, tab, tid); }
        pg8::EpiRes<2> E{nullptr, Yb, tab, ln2_g, ln2_b, nullptr};
        pg8::gemm_phase<pg8::EpiRes<2>, pg8::SchedPlain, true>(lds, D_FF, D_FF, D_FF, S, E);
    }
    SEAM(11);
    if (IN(12)) ln_rows(Yb, ln3_g, ln3_b, a.out, nullptr, gw, ngw, lane);
#undef IN
#undef SEAM
}

extern "C" void kernel_launch(void* const* d_in, const int* in_sizes, int n_in, void* d_out, int out_size, void* d_ws, size_t ws_size, hipStream_t stream) {
    static int grid = 0;
    if (grid == 0) {
        if (n_in != 18 || in_sizes[0] != MTOK * DM || out_size != MTOK * DM || ws_size < WS_END) {
            fprintf(stderr, "kernel_launch: unexpected shapes / workspace (n_in %d, in0 %d, out %d, ws %zu, need %zu); nothing launched\n", n_in, n_in > 0 ? in_sizes[0] : -1, out_size, ws_size, (size_t)WS_END);
            grid = -1; return; }
        int dev = 0, cus = 0, per_cu = 0;
        hipGetDevice(&dev);
        hipDeviceGetAttribute(&cus, hipDeviceAttributeMultiprocessorCount, dev);
        hipFuncSetAttribute((const void*)hymba_fwd, hipFuncAttributeMaxDynamicSharedMemorySize, LDS_BYTES);
        hipOccupancyMaxActiveBlocksPerMultiprocessor(&per_cu, (const void*)hymba_fwd, 512, LDS_BYTES);
        if (per_cu < 1) { fprintf(stderr, "kernel_launch: occupancy query says %d blocks per CU\n", per_cu); per_cu = 1; }
        grid = cus * 1;
        if (grid != 256) fprintf(stderr, "kernel_launch: %d CUs; P6 needs >= 256 workgroups\n", grid);
    }
    if (grid < 0) return;
    Args a{};
    for (int i = 0; i < 18; ++i) a.in[i] = (const float*)d_in[i];
    a.out = (float*)d_out; a.ws = (unsigned char*)d_ws;
#if MK_MULTI
    for (int p = 0; p < NPHASE; ++p) { a.ph_lo = p; a.ph_hi = p + 1;
        for (int rep = 0; rep < ((PROBE_DUP >> p) & 1 ? 2 : 1); ++rep) hipLaunchKernelGGL(hymba_fwd, dim3(grid), dim3(512), LDS_BYTES, stream, a); }
#else
    a.ph_lo = 0; a.ph_hi = NPHASE;
    (void)hipMemsetAsync((char*)d_ws + WS_CTL, 0, CTL_BYTES, stream);
    void* args[] = {&a};
    hipError_t e = hipLaunchCooperativeKernel((const void*)hymba_fwd, dim3(grid), dim3(512), args, LDS_BYTES, stream);
    if (e != hipSuccess) fprintf(stderr, "cooperative launch failed: %s (grid %d)\n", hipGetErrorString(e), grid);
#endif
}
```

```cpp
#include <hip/hip_runtime.h>
#include <hip/hip_cooperative_groups.h>
#include <cstdio>
#include <cstdint>
namespace cg = cooperative_groups;

#ifndef PROBE_DUP
#define PROBE_DUP 0
#endif
#ifndef MK_MULTI
#define MK_MULTI 0
#endif

#define LAS __attribute__((address_space(3)))
typedef unsigned short bf16_t;
typedef short bf16x8 __attribute__((ext_vector_type(8)));
typedef short s16x4 __attribute__((ext_vector_type(4)));
typedef float f32x4 __attribute__((ext_vector_type(4)));
typedef float f32x2 __attribute__((ext_vector_type(2)));
typedef float f32x16 __attribute__((ext_vector_type(16)));
typedef unsigned u32x4 __attribute__((ext_vector_type(4)));
typedef unsigned u32x2 __attribute__((ext_vector_type(2)));

constexpr int DM = 2048, NB = 8, SEQ = 2048, MTOK = NB * SEQ;
constexpr int MEML = 256, MROWS = NB * MEML;
constexpr int D_IN = 4608, D_FF = 5632, NQK = 3328, NVT = 1280;
constexpr float ALPHA = 1.189207115002721f;
constexpr float LN_EPS = 1e-5f, RMS_EPS = 1e-6f;
constexpr float LOG2E = 1.4426950408889634f;
constexpr int NPHASE = 13, NCS = 2048 + 11264;

constexpr size_t MiB = 1u << 20;
constexpr size_t WS_QK = 0;
constexpr size_t WS_VT = 104 * MiB;
constexpr size_t WS_QM = 0;
constexpr size_t WS_P = 64 * MiB;
constexpr size_t WS_OC = 96 * MiB;
constexpr size_t WS_F = 0;
constexpr size_t WS_Y = 176 * MiB;
constexpr size_t WS_ALL = 304 * MiB;
constexpr size_t WS_KM = 160 * MiB;
constexpr size_t WS_VMT = 168 * MiB;
constexpr size_t WS_WO = 410 * MiB, WS_WQM = 418 * MiB, WS_WOM = 426 * MiB;
constexpr size_t WS_WGU = 434 * MiB;
constexpr size_t WS_WD = 478 * MiB;
constexpr size_t WS_CTL = 500 * MiB, CTL_BYTES = 64 * 1024;
constexpr size_t WS_CSP = 501 * MiB;
constexpr size_t WS_CSF = 505 * MiB;
constexpr size_t WS_SP1 = 368 * MiB, WS_SP2 = 372 * MiB;
constexpr size_t WS_END = 506 * MiB;

typedef __bf16 bf16x2_t __attribute__((ext_vector_type(2)));
__device__ __forceinline__ unsigned cvt_pk_bf16(float lo, float hi) { const f32x2 v = {lo, hi}; const bf16x2_t b = __builtin_convertvector(v, bf16x2_t); return __builtin_bit_cast(unsigned, b); }
__device__ __forceinline__ float fexp2(float x) { return __builtin_amdgcn_exp2f(x); }
__device__ __forceinline__ float flog2(float x) { return __builtin_amdgcn_logf(x); }
__device__ __forceinline__ float wave_sum(float v) {
#pragma unroll
    for (int o = 1; o < 64; o <<= 1) v += __shfl_xor(v, o);
    return v;
}
#define LDS_WAIT() asm volatile("s_waitcnt lgkmcnt(0)" ::: "memory")

namespace pg8 {
constexpr int BM = 256, BK = 64, HALF = 128, HTB = HALF * BK * 2, STAGE_BYTES = 8 * HTB, NXCD = 8, WGM = 8;
__host__ __device__ __forceinline__ int lds_byte(int r, int c) { const int st = (r >> 4) * 2 + (c >> 5), rr = r & 15, cc = c & 31, ob = rr * 64 + cc * 2; return st * 1024 + (ob ^ (((ob >> 9) & 1) << 5)); }
__host__ __device__ __forceinline__ void stage_rc(int b, int& R, int& C) { const int st = b / 1024, sb = b % 1024, swz = sb ^ (((sb >> 9) & 1) << 5); R = (st >> 1) * 16 + swz / 64; C = (st & 1) * 32 + (swz % 64) / 2; }
__host__ __device__ __forceinline__ int perm32(int rho) { const int n = rho >> 4, i = rho & 15; return 8 * (i >> 2) + 4 * n + (i & 3); }

struct Unit { int pm, pn, z; };

__device__ __forceinline__ void map_tile(int l, int nM, int nN, int& pm, int& pn) {
    const int nwg = nM * nN; int wgid = l;
    { const int q = nwg / NXCD, r = nwg % NXCD, xcd = wgid % NXCD, off = wgid / NXCD; wgid = (xcd < r ? xcd * (q + 1) : r * (q + 1) + (xcd - r) * q) + off; }
    const int nig = WGM * nN, gid = wgid / nig, fm = gid * WGM, gsz = (nM - fm) < WGM ? (nM - fm) : WGM;
    pm = fm + ((wgid % nig) % gsz); pn = (wgid % nig) / gsz;
}

struct SchedPlain {
    const char* A; const char* Bt; int nM, nN, G, c; size_t tA, tB;
    __device__ void init(const bf16_t* A_, int lda, const bf16_t* B_, int ldb, int M, int N, int G_, int c_) { A = (const char*)A_; Bt = (const char*)B_; nM = M / BM; nN = N / BM; G = G_; c = c_; tA = (size_t)BM * lda * 2; tB = (size_t)BM * ldb * 2; }
    __device__ __forceinline__ bool next(int i, Unit& u) const { const long L = (long)i * G + c; if (L >= (long)nM * nN) return false; map_tile((int)L, nM, nN, u.pm, u.pn); u.z = 0; return true; }
    __device__ __forceinline__ const char* pa(const Unit& u) const { return A + (size_t)u.pm * tA; }
    __device__ __forceinline__ const char* pb(const Unit& u) const { return Bt + (size_t)u.pn * tB; }
};

struct SchedP1 {
    const char* all; int G, c;
    static constexpr size_t TB = (size_t)BM * DM * 2;
    __device__ __forceinline__ bool next(int i, Unit& u) const {
        const long L = (long)i * G + c; if (L >= 1280) return false;
        int l = (int)L;
        if (l < 832) { u.z = 0; map_tile(l, 64, 13, u.pm, u.pn); }
        else if (l < 1152) { u.z = 1; map_tile(l - 832, 5, 64, u.pm, u.pn); }
        else if (l < 1216) { u.z = 2; map_tile(l - 1152, 8, 8, u.pm, u.pn); }
        else { u.z = 3; map_tile(l - 1216, 8, 8, u.pm, u.pn); }
        return true;
    }
    __device__ __forceinline__ const char* pa(const Unit& u) const {
        const int t = u.z == 0 ? u.pm : (u.z == 1 ? 72 + (u.pm == 0 ? 5 : 13 + u.pm) : (u.z == 2 ? 64 + u.pm : 98 + u.pm));
        return all + (size_t)t * TB;
    }
    __device__ __forceinline__ const char* pb(const Unit& u) const {
        const int t = u.z == 0 ? 72 + (u.pn < 5 ? u.pn : u.pn + 1) : (u.z == 1 ? u.pn : (u.z == 2 ? 90 + u.pn : 64 + u.pn));
        return all + (size_t)t * TB;
    }
};

struct SchedQK {
    const char* Qm; const char* Km; int G, c;
    __device__ __forceinline__ bool next(int i, Unit& u) const { const long L = (long)i * G + c; if (L >= 256) return false; u.z = (int)L >> 3; u.pm = (int)L & 7; u.pn = 0; return true; }
    __device__ __forceinline__ const char* pa(const Unit& u) const { const int b = u.z >> 2, h = u.z & 3; return Qm + ((size_t)(b * SEQ + u.pm * 256) * DM + h * 512) * 2; }
    __device__ __forceinline__ const char* pb(const Unit& u) const { const int b = u.z >> 2, h = u.z & 3; return Km + ((size_t)(b * MEML) * DM + h * 512) * 2; }
};
struct SchedPV {
    const char* P; const char* Vt; int G, c;
    __device__ __forceinline__ bool next(int i, Unit& u) const { const long L = (long)i * G + c; if (L >= 512) return false; u.z = (int)L >> 4; u.pm = ((int)L >> 1) & 7; u.pn = (int)L & 1; return true; }
    __device__ __forceinline__ const char* pa(const Unit& u) const { return P + ((size_t)u.z * SEQ + u.pm * 256) * MEML * 2; }
    __device__ __forceinline__ const char* pb(const Unit& u) const { const int b = u.z >> 2, h = u.z & 3; return Vt + ((size_t)(h * 512 + u.pn * 256) * MROWS + b * MEML) * 2; }
};

typedef f32x4 Acc[2][2][4][2];
__device__ __forceinline__ void store_tile_bf16(const Acc& acc, bf16_t* base, size_t ldc, int wr, int wc, int fr, int fq) {
    bf16_t* p0 = base + (size_t)(wr * 64 + fr) * ldc + wc * 32 + 8 * fq;
#pragma unroll
    for (int ai = 0; ai < 2; ++ai)
#pragma unroll
        for (int m = 0; m < 4; ++m) { bf16_t* rowp = p0 + (size_t)(ai * HALF + m * 16) * ldc;
#pragma unroll
            for (int bj = 0; bj < 2; ++bj) { const f32x4 v0 = acc[ai][bj][m][0], v1 = acc[ai][bj][m][1]; u32x4 w;
                w.x = cvt_pk_bf16(v0[0], v0[1]); w.y = cvt_pk_bf16(v0[2], v0[3]); w.z = cvt_pk_bf16(v1[0], v1[1]); w.w = cvt_pk_bf16(v1[2], v1[3]);
                *(u32x4*)(rowp + bj * HALF) = w; } }
}
struct EpiP1 {
    static constexpr bool PERM = true, AFTER_DRAIN = false;
    bf16_t *QK, *VT, *KM, *VMT;
    __device__ __forceinline__ void operator()(const Acc& acc, const Unit& u, int wr, int wc, int fr, int fq) const {
        if (u.z == 0) {
            const int b = u.pm >> 3, hs0 = 4 * u.pn + (wc >> 1), hi = wc & 1;
#pragma unroll
            for (int ai = 0; ai < 2; ++ai)
#pragma unroll
                for (int m = 0; m < 4; ++m) { const int t = (u.pm & 7) * 256 + ai * HALF + wr * 64 + m * 16 + fr;
#pragma unroll
                    for (int bj = 0; bj < 2; ++bj) { const f32x4 v0 = acc[ai][bj][m][0], v1 = acc[ai][bj][m][1]; u32x4 w;
                        w.x = cvt_pk_bf16(v0[0], v0[1]); w.y = cvt_pk_bf16(v0[2], v0[3]); w.z = cvt_pk_bf16(v1[0], v1[1]); w.w = cvt_pk_bf16(v1[2], v1[3]);
                        const size_t off = ((((size_t)(b * 52 + hs0 + 2 * bj) * 64 + (t >> 5)) * 4 + fq) * 64 + hi * 32 + (t & 31)) * 8;
                        *(u32x4*)(QK + off) = w; } }
        } else if (u.z == 1) {
            const int b = u.pn >> 3, s = fq >> 1, half = fq & 1;
#pragma unroll
            for (int ai = 0; ai < 2; ++ai)
#pragma unroll
                for (int m = 0; m < 4; ++m) { const int vrow = u.pm * 256 + ai * HALF + wr * 64 + m * 16 + fr, vh = vrow >> 6, db = (vrow >> 5) & 1, dl = vrow & 31;
#pragma unroll
                    for (int bj = 0; bj < 2; ++bj) { const int blk = 8 * (u.pn & 7) + 4 * bj + wc;
                        const size_t off = ((((size_t)(b * 20 + vh) * 64 + blk) * 4 + db * 2 + s) * 64 + dl) * 8 + 4 * half;
#pragma unroll
                        for (int n = 0; n < 2; ++n) { const f32x4 v = acc[ai][bj][m][n]; u32x2 w; w.x = cvt_pk_bf16(v[0], v[1]); w.y = cvt_pk_bf16(v[2], v[3]);
                            *(u32x2*)(VT + off + n * 256) = w; } } }
        } else {
            bf16_t* base; size_t ldc;
            if (u.z == 2) { ldc = DM; base = KM + (size_t)(u.pm * 256) * ldc + u.pn * 256; }
            else { ldc = MROWS; base = VMT + (size_t)(u.pm * 256) * ldc + u.pn * 256; }
            store_tile_bf16(acc, base, ldc, wr, wc, fr, fq);
        }
    }
};
struct EpiPlain {
    static constexpr bool PERM = true, AFTER_DRAIN = false;
    bf16_t* O; int ldc;
    __device__ __forceinline__ void operator()(const Acc& acc, const Unit& u, int wr, int wc, int fr, int fq) const {
        store_tile_bf16(acc, O + (size_t)(u.pm * 256) * ldc + u.pn * 256, ldc, wr, wc, fr, fq);
    }
};
struct EpiPV {
    static constexpr bool PERM = true, AFTER_DRAIN = false;
    bf16_t* O;
    __device__ __forceinline__ void operator()(const Acc& acc, const Unit& u, int wr, int wc, int fr, int fq) const {
        const int b = u.z >> 2, h = u.z & 3;
        store_tile_bf16(acc, O + (size_t)(b * SEQ + u.pm * 256) * DM + h * 512 + u.pn * 256, DM, wr, wc, fr, fq);
    }
};
__device__ __forceinline__ void row_stats(const LAS f32x2* tab, int trow, float& mean, float& rstd) { const f32x2 s = tab[trow]; mean = s[0]; rstd = s[1]; }
struct EpiLnPlain {
    static constexpr bool PERM = true, AFTER_DRAIN = false;
    bf16_t* O; int ldc; const LAS f32x2* S; const float* cs; const float* bw;
    __device__ __forceinline__ void operator()(const Acc& acc, const Unit& u, int wr, int wc, int fr, int fq) const {
        const int colt = u.pn * 256 + wc * 32 + 8 * fq;
        bf16_t* p0 = O + (size_t)(u.pm * 256 + wr * 64 + fr) * ldc + colt;
#pragma unroll
        for (int ai = 0; ai < 2; ++ai)
#pragma unroll
            for (int m = 0; m < 4; ++m) { float mean, rstd; row_stats(S, ai * HALF + wr * 64 + m * 16 + fr, mean, rstd);
                bf16_t* rowp = p0 + (size_t)(ai * HALF + m * 16) * ldc;
#pragma unroll
                for (int bj = 0; bj < 2; ++bj) { const int col = colt + bj * HALF;
                    const f32x4 c0 = *(const f32x4*)(cs + col), c1 = *(const f32x4*)(cs + col + 4), b0 = *(const f32x4*)(bw + col), b1 = *(const f32x4*)(bw + col + 4);
                    const f32x4 v0 = (acc[ai][bj][m][0] - c0 * mean) * rstd + b0, v1 = (acc[ai][bj][m][1] - c1 * mean) * rstd + b1; u32x4 w;
                    w.x = cvt_pk_bf16(v0[0], v0[1]); w.y = cvt_pk_bf16(v0[2], v0[3]); w.z = cvt_pk_bf16(v1[0], v1[1]); w.w = cvt_pk_bf16(v1[2], v1[3]);
                    *(u32x4*)(rowp + bj * HALF) = w; } }
    }
};
template <int MODE> struct EpiRes {
    static constexpr bool PERM = true, AFTER_DRAIN = false;
    const float* X; bf16_t* Yb; const LAS f32x2* Sin; const float* g; const float* b; float* Sout;
    __device__ __forceinline__ void operator()(const Acc& acc, const Unit& u, int wr, int wc, int fr, int fq) const {
        const int col0 = u.pn * 256 + wc * 32 + 8 * fq;
#pragma unroll
        for (int ai = 0; ai < 2; ++ai)
#pragma unroll
            for (int m = 0; m < 4; ++m) { const int trow = ai * HALF + wr * 64 + m * 16 + fr, row = u.pm * 256 + trow; const size_t off = (size_t)row * DM + col0;
                float mean = 0.f, rstd = 1.f; if (MODE > 0) row_stats(Sin, trow, mean, rstd);
                f32x4 rv[2][2];
#pragma unroll
                for (int bj = 0; bj < 2; ++bj) { const int dc = bj * HALF;
                    if (MODE == 0) { rv[bj][0] = *(const f32x4*)(X + off + dc); rv[bj][1] = *(const f32x4*)(X + off + dc + 4); }
                    else { const u32x4 w = *(const u32x4*)(Yb + off + dc);
                        const f32x4 y0 = {__builtin_bit_cast(float, w.x << 16), __builtin_bit_cast(float, w.x & 0xffff0000u), __builtin_bit_cast(float, w.y << 16), __builtin_bit_cast(float, w.y & 0xffff0000u)};
                        const f32x4 y1 = {__builtin_bit_cast(float, w.z << 16), __builtin_bit_cast(float, w.z & 0xffff0000u), __builtin_bit_cast(float, w.w << 16), __builtin_bit_cast(float, w.w & 0xffff0000u)};
                        rv[bj][0] = (y0 - mean) * rstd * *(const f32x4*)(g + col0 + dc) + *(const f32x4*)(b + col0 + dc);
                        rv[bj][1] = (y1 - mean) * rstd * *(const f32x4*)(g + col0 + dc + 4) + *(const f32x4*)(b + col0 + dc + 4); } }
                float ps = 0.f, pq = 0.f;
#pragma unroll
                for (int bj = 0; bj < 2; ++bj) { const f32x4 y0 = rv[bj][0] * ALPHA + acc[ai][bj][m][0], y1 = rv[bj][1] * ALPHA + acc[ai][bj][m][1]; u32x4 w;
                    w.x = cvt_pk_bf16(y0[0], y0[1]); w.y = cvt_pk_bf16(y0[2], y0[3]); w.z = cvt_pk_bf16(y1[0], y1[1]); w.w = cvt_pk_bf16(y1[2], y1[3]);
                    *(u32x4*)(Yb + off + bj * HALF) = w;
                    if (MODE < 2) { ps += ((y0[0] + y0[1]) + (y0[2] + y0[3])) + ((y1[0] + y1[1]) + (y1[2] + y1[3]));
                        pq += ((y0[0] * y0[0] + y0[1] * y0[1]) + (y0[2] * y0[2] + y0[3] * y0[3])) + ((y1[0] * y1[0] + y1[1] * y1[1]) + (y1[2] * y1[2] + y1[3] * y1[3])); } }
                if (MODE < 2) { ps += __shfl_xor(ps, 16); ps += __shfl_xor(ps, 32); pq += __shfl_xor(pq, 16); pq += __shfl_xor(pq, 32);
                    if (fq == 0) *(f32x2*)(Sout + ((size_t)(4 * u.pn + wc) * MTOK + row) * 2) = (f32x2){ps, pq}; }
            }
    }
};
struct EpiSwiglu {
    static constexpr bool PERM = true, AFTER_DRAIN = false;
    bf16_t* F; const LAS f32x2* S; const float* cs; const float* bw;
    __device__ __forceinline__ void operator()(const Acc& acc, const Unit& u, int wr, int wc, int fr, int fq) const {
        bf16_t* p0 = F + (size_t)(u.pm * 256 + wr * 64 + fr) * D_FF + u.pn * 128 + wc * 32 + 8 * fq;
        const int colt = u.pn * 256 + wc * 32 + 8 * fq;
        f32x4 cg[2], cu[2], bg[2], bu[2];
#pragma unroll
        for (int n = 0; n < 2; ++n) { cg[n] = *(const f32x4*)(cs + colt + 4 * n); cu[n] = *(const f32x4*)(cs + colt + HALF + 4 * n); bg[n] = *(const f32x4*)(bw + colt + 4 * n); bu[n] = *(const f32x4*)(bw + colt + HALF + 4 * n); }
#pragma unroll
        for (int ai = 0; ai < 2; ++ai)
#pragma unroll
            for (int m = 0; m < 4; ++m) { float mean, rstd; row_stats(S, ai * HALF + wr * 64 + m * 16 + fr, mean, rstd); float o[8];
#pragma unroll
                for (int n = 0; n < 2; ++n) { const f32x4 gv = (acc[ai][0][m][n] - cg[n] * mean) * rstd + bg[n], uv = (acc[ai][1][m][n] - cu[n] * mean) * rstd + bu[n];
#pragma unroll
                    for (int j = 0; j < 4; ++j) o[n * 4 + j] = gv[j] * __builtin_amdgcn_rcpf(1.0f + fexp2(-gv[j] * LOG2E)) * uv[j]; }
                u32x4 w; w.x = cvt_pk_bf16(o[0], o[1]); w.y = cvt_pk_bf16(o[2], o[3]); w.z = cvt_pk_bf16(o[4], o[5]); w.w = cvt_pk_bf16(o[6], o[7]);
                *(u32x4*)(p0 + (size_t)(ai * HALF + m * 16) * D_FF) = w; }
    }
};
struct EpiSoftmax {
    static constexpr bool PERM = true, AFTER_DRAIN = true;
    bf16_t* P;
    __device__ __forceinline__ void fused(Acc& acc, const Unit& u, int wr, int wc, int fr, int fq, LAS unsigned char* lds, int wid, int lane) const {
        const float c = 0.04419417382415922f * LOG2E;
        LAS f32x2* T = (LAS f32x2*)lds;
        float mw[2][4];
#pragma unroll
        for (int ai = 0; ai < 2; ++ai)
#pragma unroll
            for (int m = 0; m < 4; ++m) {
                float mx = -INFINITY;
#pragma unroll
                for (int bj = 0; bj < 2; ++bj)
#pragma unroll
                    for (int n = 0; n < 2; ++n) { const f32x4 x = acc[ai][bj][m][n]; mx = fmaxf(mx, fmaxf(fmaxf(x[0], x[1]), fmaxf(x[2], x[3]))); }
                mx = fmaxf(mx, __shfl_xor(mx, 16)); mx = fmaxf(mx, __shfl_xor(mx, 32));
                float s = 0.f;
#pragma unroll
                for (int bj = 0; bj < 2; ++bj)
#pragma unroll
                    for (int n = 0; n < 2; ++n) { f32x4 x = acc[ai][bj][m][n];
#pragma unroll
                        for (int j = 0; j < 4; ++j) { x[j] = fexp2((x[j] - mx) * c); s += x[j]; }
                        acc[ai][bj][m][n] = x; }
                s += __shfl_xor(s, 16); s += __shfl_xor(s, 32);
                mw[ai][m] = mx;
                if (fq == 0) T[(ai * HALF + wr * 64 + m * 16 + fr) * 4 + wc] = (f32x2){mx, s};
            }
        LDS_WAIT(); __builtin_amdgcn_s_barrier(); asm volatile("" ::: "memory");
        bf16_t* p0 = P + ((size_t)u.z * SEQ + u.pm * 256 + wr * 64 + fr) * MEML + wc * 32 + 8 * fq;
#pragma unroll
        for (int ai = 0; ai < 2; ++ai)
#pragma unroll
            for (int m = 0; m < 4; ++m) { const int row = ai * HALF + wr * 64 + m * 16 + fr;
                const f32x2 t0 = T[row * 4 + 0], t1 = T[row * 4 + 1], t2 = T[row * 4 + 2], t3 = T[row * 4 + 3];
                const float M = fmaxf(fmaxf(t0.x, t1.x), fmaxf(t2.x, t3.x));
                const float tot = t0.y * fexp2((t0.x - M) * c) + t1.y * fexp2((t1.x - M) * c) + t2.y * fexp2((t2.x - M) * c) + t3.y * fexp2((t3.x - M) * c);
                const float f = fexp2((mw[ai][m] - M) * c) / tot;
                bf16_t* rowp = p0 + (size_t)(ai * HALF + m * 16) * MEML;
#pragma unroll
                for (int bj = 0; bj < 2; ++bj) { const f32x4 v0 = acc[ai][bj][m][0] * f, v1 = acc[ai][bj][m][1] * f; u32x4 w;
                    w.x = cvt_pk_bf16(v0[0], v0[1]); w.y = cvt_pk_bf16(v0[2], v0[3]); w.z = cvt_pk_bf16(v1[0], v1[1]); w.w = cvt_pk_bf16(v1[2], v1[3]);
                    *(u32x4*)(rowp + bj * HALF) = w; } }
    }
};

template <class Epi, class Sched, bool ALIGN_EPI>
__device__ __forceinline__ void gemm_phase(LAS unsigned char* lds, const int lda, const int ldb, const int K, const Sched& S, const Epi& E) {
    const int tid = threadIdx.x, wid = __builtin_amdgcn_readfirstlane(tid >> 6), lane = tid & 63, wr = wid >> 2, wc = wid & 3, fr = lane & 15, fq = lane >> 4;
    const int nt = K / BK;
    unsigned voffA[2], voffB[2];
#pragma unroll
    for (int i = 0; i < 2; ++i) { int R, C; stage_rc(tid * 16 + i * 8192, R, C); const int Rb = Epi::PERM ? ((R & ~31) + perm32(R & 31)) : R;
        voffA[i] = (unsigned)(R * lda + C) * 2u; voffB[i] = (unsigned)(Rb * ldb + C) * 2u; }
    const size_t kstep = (size_t)(BK * 2);
    const size_t hsA = (size_t)HALF * lda * 2, hsB = (size_t)HALF * ldb * 2;
    const unsigned ldsw = (unsigned)wid * 1024u;
    const int aoff = lds_byte(wr * 64 + fr, fq * 8), boff = lds_byte(wc * 32 + fr, fq * 8);
#define PG8_SA(b, h) (((b) * 2 + (h)) * HTB)
#define PG8_SB(b, h) ((4 + (b) * 2 + (h)) * HTB)
#define PG8_STAGE(bufoff, gbase, voff) do { _Pragma("unroll") for (int _i = 0; _i < 2; ++_i) \
        __builtin_amdgcn_global_load_lds((const unsigned*)((const char*)(gbase) + (voff)[_i]), (LAS unsigned*)(lds + (bufoff) + ldsw + _i * 8192), 16, 0, 0); } while (0)
#define PG8_LDA(dst, b, h) do { _Pragma("unroll") for (int m = 0; m < 4; ++m) _Pragma("unroll") for (int k = 0; k < 2; ++k) dst[m][k] = *(const LAS bf16x8*)(lds + PG8_SA(b, h) + aoff + m * 2048 + k * 1024); } while (0)
#define PG8_LDB(dst, b, h) do { _Pragma("unroll") for (int n = 0; n < 2; ++n) _Pragma("unroll") for (int k = 0; k < 2; ++k) dst[n][k] = *(const LAS bf16x8*)(lds + PG8_SB(b, h) + boff + n * 2048 + k * 1024); } while (0)
#define PG8_MMA(ai, bj, At, Bt) do { __builtin_amdgcn_s_setprio(1); _Pragma("unroll") for (int m = 0; m < 4; ++m) _Pragma("unroll") for (int n = 0; n < 2; ++n) _Pragma("unroll") for (int k = 0; k < 2; ++k) \
        acc[ai][bj][m][n] = __builtin_amdgcn_mfma_f32_16x16x32_bf16(Bt[n][k], At[m][k], acc[ai][bj][m][n], 0, 0, 0); __builtin_amdgcn_s_setprio(0); } while (0)
#define PG8_WAIT_V(n) asm volatile("s_waitcnt vmcnt(" #n ")" ::: "memory")
#define PG8_WAIT_L(n) asm volatile("s_waitcnt lgkmcnt(" #n ")" ::: "memory")
#define PG8_BAR __builtin_amdgcn_s_barrier()
#define PG8_SCHED __builtin_amdgcn_sched_barrier(0)
    Unit cur, nxt; int ui = 0;
    if (!S.next(0, cur)) return;
    Acc acc;
#pragma unroll
    for (int a = 0; a < 2; ++a)
#pragma unroll
        for (int b = 0; b < 2; ++b)
#pragma unroll
            for (int m = 0; m < 4; ++m)
#pragma unroll
                for (int n = 0; n < 2; ++n) acc[a][b][m][n] = (f32x4){0.f, 0.f, 0.f, 0.f};
    bf16x8 At[4][2], B0[2][2], B1[2][2];
    const char* cA = S.pa(cur); const char* cB = S.pb(cur);
    PG8_STAGE(PG8_SB(0, 0), cB, voffB); PG8_STAGE(PG8_SB(0, 1), cB + hsB, voffB); PG8_STAGE(PG8_SA(0, 0), cA, voffA); PG8_STAGE(PG8_SA(0, 1), cA + hsA, voffA);
    if (wr == 1) PG8_BAR;
    PG8_WAIT_V(2); PG8_BAR;
    PG8_STAGE(PG8_SB(1, 0), cB + kstep, voffB); PG8_STAGE(PG8_SA(1, 0), cA + kstep, voffA); PG8_STAGE(PG8_SB(1, 1), cB + hsB + kstep, voffB);
    PG8_WAIT_V(6); PG8_BAR;
    for (;;) {
        const bool has_next = S.next(ui + 1, nxt);
        const char* nA = has_next ? S.pa(nxt) : cA; const char* nB = has_next ? S.pb(nxt) : cB;
#pragma unroll 1
        for (int t = 0; t < nt; t += 2) {
            const bool last = (t == nt - 2);
            const char* a1 = cA + (size_t)(t + 1) * kstep;
            const char* a2 = last ? nA : cA + (size_t)(t + 2) * kstep; const char* b2 = last ? nB : cB + (size_t)(t + 2) * kstep;
            const char* a3 = a2 + kstep; const char* b3 = b2 + kstep;
            PG8_LDB(B0, 0, 0); PG8_LDB(B1, 0, 1); PG8_SCHED; PG8_LDA(At, 0, 0); PG8_STAGE(PG8_SA(1, 1), a1 + hsA, voffA);
            PG8_WAIT_V(8); PG8_WAIT_L(0); PG8_BAR; PG8_MMA(0, 0, At, B0); PG8_MMA(0, 1, At, B1); PG8_BAR; PG8_SCHED;
            PG8_LDA(At, 0, 1); PG8_STAGE(PG8_SB(0, 0), b2, voffB); PG8_STAGE(PG8_SB(0, 1), b2 + hsB, voffB); PG8_STAGE(PG8_SA(0, 0), a2, voffA);
            PG8_WAIT_V(8); PG8_WAIT_L(0); PG8_BAR; PG8_MMA(1, 0, At, B0); PG8_MMA(1, 1, At, B1); PG8_BAR; PG8_SCHED;
            PG8_LDB(B0, 1, 0); PG8_LDB(B1, 1, 1); PG8_SCHED; PG8_LDA(At, 1, 0); PG8_STAGE(PG8_SA(0, 1), a2 + hsA, voffA);
            PG8_WAIT_V(8); PG8_WAIT_L(0); PG8_BAR; PG8_MMA(0, 0, At, B0); PG8_MMA(0, 1, At, B1); PG8_BAR; PG8_SCHED;
            PG8_LDA(At, 1, 1); PG8_STAGE(PG8_SB(1, 0), b3, voffB); PG8_STAGE(PG8_SB(1, 1), b3 + hsB, voffB); PG8_STAGE(PG8_SA(1, 0), a3, voffA);
            PG8_WAIT_V(8); PG8_WAIT_L(0); PG8_BAR; PG8_MMA(1, 0, At, B0); PG8_MMA(1, 1, At, B1); PG8_BAR; PG8_SCHED;
        }
        if constexpr (ALIGN_EPI) { if (wr == 0) PG8_BAR; }
        if constexpr (!Epi::AFTER_DRAIN) { E(acc, cur, wr, wc, fr, fq); }
        if (!has_next) break;
#pragma unroll
        for (int a = 0; a < 2; ++a)
#pragma unroll
            for (int b = 0; b < 2; ++b)
#pragma unroll
                for (int m = 0; m < 4; ++m)
#pragma unroll
                    for (int n = 0; n < 2; ++n) acc[a][b][m][n] = (f32x4){0.f, 0.f, 0.f, 0.f};
        cur = nxt; cA = nA; cB = nB; ++ui;
        if constexpr (ALIGN_EPI) { if (wr == 1) PG8_BAR; }
    }
    PG8_WAIT_V(0);
    if constexpr (!ALIGN_EPI) { if (wr == 0) PG8_BAR; }
    PG8_BAR;
    if constexpr (Epi::AFTER_DRAIN) { E.fused(acc, cur, wr, wc, fr, fq, lds, wid, lane); }
#undef PG8_SA
#undef PG8_SB
#undef PG8_STAGE
#undef PG8_LDA
#undef PG8_LDB
#undef PG8_MMA
#undef PG8_WAIT_V
#undef PG8_WAIT_L
#undef PG8_BAR
#undef PG8_SCHED
}
}

__device__ __forceinline__ void transpose_item(const float* W, int N, bf16_t* WT, int ldt, int k0, int n0, int dest_row0, LAS float* scr, int lane) {
#pragma unroll 8
    for (int i = 0; i < 32; ++i) { const int kk = 2 * i + (lane >> 5); scr[kk * 33 + (lane & 31)] = W[(size_t)(k0 + kk) * N + n0 + (lane & 31)]; }
    LDS_WAIT(); asm volatile("" ::: "memory");
    const int c = lane & 7;
#pragma unroll
    for (int j = 0; j < 4; ++j) { const int n = (lane >> 3) + 8 * j; const LAS float* s = scr + (8 * c) * 33 + n;
        u32x4 o; o.x = cvt_pk_bf16(s[0 * 33], s[1 * 33]); o.y = cvt_pk_bf16(s[2 * 33], s[3 * 33]); o.z = cvt_pk_bf16(s[4 * 33], s[5 * 33]); o.w = cvt_pk_bf16(s[6 * 33], s[7 * 33]);
        *(u32x4*)(WT + (size_t)(dest_row0 + n) * ldt + k0 + 8 * c) = o; }
    LDS_WAIT(); asm volatile("" ::: "memory");
}

__device__ __forceinline__ void transpose_item_ln(const float* W, int N, bf16_t* WT, int ldt, int k0, int n0, int dest_row0, LAS float* scr, int lane, const float* g, const float* b, float* csp_out, float* bwp_out) {
    float csp = 0.f, bwp = 0.f;
#pragma unroll 8
    for (int i = 0; i < 32; ++i) { const int kk = 2 * i + (lane >> 5); const float w = W[(size_t)(k0 + kk) * N + n0 + (lane & 31)], wg = w * g[k0 + kk];
        scr[kk * 33 + (lane & 31)] = wg; csp += wg; bwp += w * b[k0 + kk]; }
    csp += __shfl_xor(csp, 32); bwp += __shfl_xor(bwp, 32);
    if (lane < 32) { csp_out[lane] = csp; bwp_out[lane] = bwp; }
    LDS_WAIT(); asm volatile("" ::: "memory");
    const int c = lane & 7;
#pragma unroll
    for (int j = 0; j < 4; ++j) { const int n = (lane >> 3) + 8 * j; const LAS float* s = scr + (8 * c) * 33 + n;
        u32x4 o; o.x = cvt_pk_bf16(s[0 * 33], s[1 * 33]); o.y = cvt_pk_bf16(s[2 * 33], s[3 * 33]); o.z = cvt_pk_bf16(s[4 * 33], s[5 * 33]); o.w = cvt_pk_bf16(s[6 * 33], s[7 * 33]);
        *(u32x4*)(WT + (size_t)(dest_row0 + n) * ldt + k0 + 8 * c) = o; }
    LDS_WAIT(); asm volatile("" ::: "memory");
}

__device__ __forceinline__ int crow(int r, int hi) { return (r & 3) + 8 * (r >> 2) + 4 * hi; }

__device__ __forceinline__ void load_k(bf16x8 (&kf)[4], const bf16_t* blk) {
#pragma unroll
    for (int s = 0; s < 4; ++s) kf[s] = *(const bf16x8*)(blk + 512 * s);
}
__device__ __forceinline__ void load_v(bf16x8 (&vf)[2][2], const bf16_t* blk) {
#pragma unroll
    for (int db = 0; db < 2; ++db)
#pragma unroll
        for (int s = 0; s < 2; ++s) vf[db][s] = *(const bf16x8*)(blk + 512 * (db * 2 + s));
}
__device__ __forceinline__ bf16x8 pack8(const float* p) {
    const unsigned a = cvt_pk_bf16(p[0], p[1]), b = cvt_pk_bf16(p[2], p[3]), c = cvt_pk_bf16(p[4], p[5]), d = cvt_pk_bf16(p[6], p[7]);
    u32x4 w = {a, b, c, d}; return __builtin_bit_cast(bf16x8, w);
}
__device__ __forceinline__ void rms_store(const f32x16& o0, const f32x16& o1, const float* g, bf16_t* Obase  , int lane, LAS unsigned char* stg) {
    const int q = lane & 31, hi = lane >> 5;
    float ss = 0.f;
#pragma unroll
    for (int r = 0; r < 16; ++r) ss += o0[r] * o0[r] + o1[r] * o1[r];
    ss += __shfl_xor(ss, 32);
    const float rs = 1.0f / sqrtf(ss * (1.0f / 64.0f) + RMS_EPS);
#pragma unroll
    for (int db = 0; db < 2; ++db)
#pragma unroll
        for (int i = 0; i < 4; ++i) { const int d = 32 * db + 8 * i + 4 * hi; const f32x4 gg = *(const f32x4*)(g + d);
            const float a0 = (db ? o1[4 * i + 0] : o0[4 * i + 0]) * rs * gg[0], a1 = (db ? o1[4 * i + 1] : o0[4 * i + 1]) * rs * gg[1];
            const float a2 = (db ? o1[4 * i + 2] : o0[4 * i + 2]) * rs * gg[2], a3 = (db ? o1[4 * i + 3] : o0[4 * i + 3]) * rs * gg[3];
            u32x2 w; w.x = cvt_pk_bf16(a0, a1); w.y = cvt_pk_bf16(a2, a3); *(LAS u32x2*)(stg + q * 144 + d * 2) = w; }
    LDS_WAIT(); asm volatile("" ::: "memory");
#pragma unroll
    for (int k = 0; k < 4; ++k) { const int row = (lane >> 3) + 8 * k, ch = lane & 7;
        const u32x4 w = *(const LAS u32x4*)(stg + row * 144 + ch * 16);
        *(u32x4*)(Obase + (size_t)row * DM + ch * 8) = w; }
    LDS_WAIT(); asm volatile("" ::: "memory");
}

template <bool DIAG>
__device__ __forceinline__ void sb_block(const f32x16& st, float& R, int lim  , int hi, bf16x8& pb0, bf16x8& pb1) {
    float L[16], lb[16];
#pragma unroll
    for (int r = 0; r < 16; ++r) {
        const float z2 = st[r] * (0.125f * LOG2E);
        const float e = fexp2(-fabsf(z2));
        const float l2 = flog2(1.0f + e);
        float b = fminf(z2, 0.f) - l2;
        float l1 = b - z2;
        if (DIAG) { const bool valid = crow(r, hi) < lim; l1 = valid ? l1 : 0.f; b = valid ? b : -INFINITY; }
        L[r] = l1; lb[r] = b;
    }
    float gs[4], pg[4];
#pragma unroll
    for (int i = 0; i < 4; ++i) { gs[i] = (L[4 * i] + L[4 * i + 1]) + (L[4 * i + 2] + L[4 * i + 3]); pg[i] = __shfl_xor(gs[i], 32); }
    float p[16];
    float suf = R;
#pragma unroll
    for (int i = 3; i >= 0; --i) {
        float off = suf + (hi == 0 ? pg[i] : 0.f);
        p[4 * i + 3] = fexp2(lb[4 * i + 3] + off); off += L[4 * i + 3];
        p[4 * i + 2] = fexp2(lb[4 * i + 2] + off); off += L[4 * i + 2];
        p[4 * i + 1] = fexp2(lb[4 * i + 1] + off); off += L[4 * i + 1];
        p[4 * i + 0] = fexp2(lb[4 * i + 0] + off);
        suf += gs[i] + pg[i];
    }
    R = suf;
    pb0 = pack8(p); pb1 = pack8(p + 8);
}

__device__ __forceinline__ void sb_wave(const bf16_t* QK, const bf16_t* VT, bf16_t* O, const float* g_sb, int b, int h, int t0, int lane, LAS unsigned char* stg) {
    const int q = lane & 31, hi = lane >> 5;
    const size_t rowq = (size_t)(b * SEQ + t0 + q);
    const bf16_t* qblk = QK + ((size_t)(b * 52 + 20 + h) * 64) * 2048 + lane * 8;
    const bf16_t* kblk = QK + ((size_t)(b * 52 + 36 + h) * 64) * 2048 + lane * 8;
    const bf16_t* vblk = VT + ((size_t)(b * 20 + 4 + h) * 64) * 2048 + lane * 8;
    bf16x8 qf[4]; load_k(qf, qblk + (size_t)(t0 >> 5) * 2048);
    f32x16 o0, o1;
#pragma unroll
    for (int r = 0; r < 16; ++r) { o0[r] = 0.f; o1[r] = 0.f; }
    float R = 0.f;
    bf16x8 kf[4], kn[4], vf[2][2], pb0, pb1;
    load_k(kf, kblk + (size_t)(t0 >> 5) * 2048);
    for (int k0 = t0; k0 >= 0; k0 -= 32) {
        load_v(vf, vblk + (size_t)(k0 >> 5) * 2048);
        if (k0 >= 32) load_k(kn, kblk + (size_t)((k0 >> 5) - 1) * 2048);
        f32x16 st;
#pragma unroll
        for (int r = 0; r < 16; ++r) st[r] = 0.f;
#pragma unroll
        for (int s = 0; s < 4; ++s) st = __builtin_amdgcn_mfma_f32_32x32x16_bf16(kf[s], qf[s], st, 0, 0, 0);
        if (k0 == t0) sb_block<true>(st, R, q, hi, pb0, pb1); else sb_block<false>(st, R, 64, hi, pb0, pb1);
        o0 = __builtin_amdgcn_mfma_f32_32x32x16_bf16(vf[0][0], pb0, o0, 0, 0, 0);
        o0 = __builtin_amdgcn_mfma_f32_32x32x16_bf16(vf[0][1], pb1, o0, 0, 0, 0);
        o1 = __builtin_amdgcn_mfma_f32_32x32x16_bf16(vf[1][0], pb0, o1, 0, 0, 0);
        o1 = __builtin_amdgcn_mfma_f32_32x32x16_bf16(vf[1][1], pb1, o1, 0, 0, 0);
        if (__all(R < -150.0f)) break;
#pragma unroll
        for (int s = 0; s < 4; ++s) kf[s] = kn[s];
    }
    rms_store(o0, o1, g_sb + h * 64, O + (size_t)(b * SEQ + t0) * DM + 1024 + h * 64, lane, stg);
}

__device__ __forceinline__ void swa_wave(const bf16_t* QK, const bf16_t* VT, bf16_t* O, const float* g_swa, const float* sinks, int b, int hq, int t0, int lane, LAS unsigned char* stg) {
    const int q = lane & 31, hi = lane >> 5, kvh = hq >> 2;
    const size_t rowq = (size_t)(b * SEQ + t0 + q);
    const bf16_t* qblk = QK + ((size_t)(b * 52 + hq) * 64) * 2048 + lane * 8;
    const bf16_t* kblk = QK + ((size_t)(b * 52 + 16 + kvh) * 64) * 2048 + lane * 8;
    const bf16_t* vblk = VT + ((size_t)(b * 20 + kvh) * 64) * 2048 + lane * 8;
    bf16x8 qf[4]; load_k(qf, qblk + (size_t)(t0 >> 5) * 2048);
    const float slope2 = fexp2(-0.5f * (float)(hq + 1)) * LOG2E;
    const float sink2 = sinks[hq] * LOG2E;
    f32x16 st[5];
#pragma unroll
    for (int jb = 0; jb < 5; ++jb) {
        const int k0 = t0 - 128 + 32 * jb;
#pragma unroll
        for (int r = 0; r < 16; ++r) st[jb][r] = 0.f;
        if (k0 >= 0) { bf16x8 kf[4]; load_k(kf, kblk + (size_t)(k0 >> 5) * 2048);
#pragma unroll
            for (int s = 0; s < 4; ++s) st[jb] = __builtin_amdgcn_mfma_f32_32x32x16_bf16(kf[s], qf[s], st[jb], 0, 0, 0); }
    }
    float mx = sink2;
#pragma unroll
    for (int jb = 0; jb < 5; ++jb) {
        const int k0 = t0 - 128 + 32 * jb;
#pragma unroll
        for (int r = 0; r < 16; ++r) { const int dist = q + 128 - 32 * jb - crow(r, hi);
            const bool valid = (k0 >= 0) && (dist >= 0) && (dist < 128);
            const float sc = valid ? (st[jb][r] * (0.125f * LOG2E) - slope2 * (float)dist) : -INFINITY;
            st[jb][r] = sc; mx = fmaxf(mx, sc); }
    }
    mx = fmaxf(mx, __shfl_xor(mx, 32));
    float sum = 0.f;
#pragma unroll
    for (int jb = 0; jb < 5; ++jb)
#pragma unroll
        for (int r = 0; r < 16; ++r) { const float p = fexp2(st[jb][r] - mx); st[jb][r] = p; sum += p; }
    sum += __shfl_xor(sum, 32);
    const float inv = 1.0f / (sum + fexp2(sink2 - mx));
    f32x16 o0, o1;
#pragma unroll
    for (int r = 0; r < 16; ++r) { o0[r] = 0.f; o1[r] = 0.f; }
#pragma unroll
    for (int jb = 0; jb < 5; ++jb) {
        const int k0 = t0 - 128 + 32 * jb;
        if (k0 >= 0) { bf16x8 vf[2][2]; load_v(vf, vblk + (size_t)(k0 >> 5) * 2048);
            float p[16];
#pragma unroll
            for (int r = 0; r < 16; ++r) p[r] = st[jb][r] * inv;
            const bf16x8 pb0 = pack8(p), pb1 = pack8(p + 8);
            o0 = __builtin_amdgcn_mfma_f32_32x32x16_bf16(vf[0][0], pb0, o0, 0, 0, 0);
            o0 = __builtin_amdgcn_mfma_f32_32x32x16_bf16(vf[0][1], pb1, o0, 0, 0, 0);
            o1 = __builtin_amdgcn_mfma_f32_32x32x16_bf16(vf[1][0], pb0, o1, 0, 0, 0);
            o1 = __builtin_amdgcn_mfma_f32_32x32x16_bf16(vf[1][1], pb1, o1, 0, 0, 0); }
    }
    rms_store(o0, o1, g_swa + hq * 64, O + (size_t)(b * SEQ + t0) * DM + hq * 64, lane, stg);
}

__device__ __forceinline__ f32x4 bf4lo(const u32x4& w) { return (f32x4){__builtin_bit_cast(float, w.x << 16), __builtin_bit_cast(float, w.x & 0xffff0000u), __builtin_bit_cast(float, w.y << 16), __builtin_bit_cast(float, w.y & 0xffff0000u)}; }
__device__ __forceinline__ f32x4 bf4hi(const u32x4& w) { return (f32x4){__builtin_bit_cast(float, w.z << 16), __builtin_bit_cast(float, w.z & 0xffff0000u), __builtin_bit_cast(float, w.w << 16), __builtin_bit_cast(float, w.w & 0xffff0000u)}; }
__device__ __forceinline__ void ln_rows(const bf16_t* Y, const float* g, const float* bta, float* Hf, bf16_t* Hb, int gw, int ngw, int lane) {
    for (int row = gw; row < MTOK; row += ngw) {
        const u32x4* yr = (const u32x4*)(Y + (size_t)row * DM) + lane;
        f32x4 v[8]; float s = 0.f;
#pragma unroll
        for (int j = 0; j < 4; ++j) { const u32x4 w = yr[64 * j]; v[2 * j] = bf4lo(w); v[2 * j + 1] = bf4hi(w); }
#pragma unroll
        for (int j = 0; j < 8; ++j) s += (v[j][0] + v[j][1]) + (v[j][2] + v[j][3]);
        const float mean = wave_sum(s) * (1.0f / DM); float s2 = 0.f;
#pragma unroll
        for (int j = 0; j < 8; ++j) { v[j] = v[j] - mean; s2 += (v[j][0] * v[j][0] + v[j][1] * v[j][1]) + (v[j][2] * v[j][2] + v[j][3] * v[j][3]); }
        const float rstd = 1.0f / sqrtf(wave_sum(s2) * (1.0f / DM) + LN_EPS);
#pragma unroll
        for (int j = 0; j < 4; ++j) { const int e = 8 * (lane + 64 * j);
            const f32x4 g0 = *(const f32x4*)(g + e), g1 = *(const f32x4*)(g + e + 4), b0 = *(const f32x4*)(bta + e), b1 = *(const f32x4*)(bta + e + 4);
            const f32x4 o0 = v[2 * j] * rstd * g0 + b0, o1 = v[2 * j + 1] * rstd * g1 + b1;
            if (Hf) { *(f32x4*)(Hf + (size_t)row * DM + e) = o0; *(f32x4*)(Hf + (size_t)row * DM + e + 4) = o1; }
            if (Hb) { u32x4 w; w.x = cvt_pk_bf16(o0[0], o0[1]); w.y = cvt_pk_bf16(o0[2], o0[3]); w.z = cvt_pk_bf16(o1[0], o1[1]); w.w = cvt_pk_bf16(o1[2], o1[3]); *(u32x4*)(Hb + (size_t)row * DM + e) = w; } }
    }
}

#define XB_TMO      128
#define XB_XCNT(j)  (256  + 64 * (j))
#define XB_XSUB(j)  (1280 + 64 * (j))
#define XB_XGEN(j)  (2304 + 64 * (j))
#define XB_TOP      3328
#define XB_TOPGEN   3392
#define XCD_BAR_WORDS 3456
#define XB_SPIN_CAP (1u << 18)

__device__ __forceinline__ unsigned xb_ld(unsigned* p)              { return __hip_atomic_load(p, __ATOMIC_RELAXED, __HIP_MEMORY_SCOPE_AGENT); }
__device__ __forceinline__ unsigned xb_add(unsigned* p, unsigned v) { return __hip_atomic_fetch_add(p, v, __ATOMIC_RELAXED, __HIP_MEMORY_SCOPE_AGENT); }
__device__ __forceinline__ unsigned xb_xcc_id() { return (unsigned)__builtin_amdgcn_s_getreg((3 << 11) | 20) & 0xFu; }
#define XB_SPIN(cond, bar) do { unsigned _sp = 0; while (cond) { __builtin_amdgcn_s_sleep(1); \
    if ((++_sp & 255u) == 0u) { if (xb_ld(&(bar)[XB_TMO])) break; if (_sp > XB_SPIN_CAP) { atomicAdd(&(bar)[XB_TMO], 1u); break; } } } } while (0)

struct XcdBarrier {
    unsigned* bar; unsigned x;
    volatile LAS unsigned* st;
};

__device__ __forceinline__ XcdBarrier xcd_barrier_post(unsigned* bar, volatile LAS unsigned* st) {
    XcdBarrier b; b.bar = bar; b.x = xb_xcc_id(); b.st = st;
    if (threadIdx.x == 0) (void)xb_add(&bar[XB_XCNT(b.x)], 1u);
    return b;
}
__device__ __forceinline__ void xcd_barrier_complete(unsigned* bar, unsigned x, unsigned& nloc, unsigned& nx) {
    const unsigned G = gridDim.x * gridDim.y * gridDim.z;
    unsigned sum, cnt, mine, sp = 0u;
    for (;;) {
        sum = 0u; cnt = 0u; mine = 0u;
#pragma unroll
        for (unsigned j = 0; j < 16; ++j) { const unsigned c = xb_ld(&bar[XB_XCNT(j)]); sum += c; cnt += (c > 0u) ? 1u : 0u; mine = (j == x) ? c : mine; }
        if (sum == G) break;
        __builtin_amdgcn_s_sleep(1);
        if ((++sp & 255u) == 0u) { if (xb_ld(&bar[XB_TMO])) break; if (sp > XB_SPIN_CAP) { atomicAdd(&bar[XB_TMO], 1u); break; } }
    }
    nloc = mine > 0u ? mine : 1u; nx = cnt > 0u ? cnt : 1u;
}

__device__ __forceinline__ void xcd_barrier(const XcdBarrier& b) {
    asm volatile("s_waitcnt vmcnt(0)" ::: "memory");
    __syncthreads();
    if (threadIdx.x == 0) {
        unsigned* bar = b.bar;
        __builtin_amdgcn_s_waitcnt(0);
        unsigned nloc = b.st[0], nx = b.st[1];
        if (nloc == 0u) { xcd_barrier_complete(bar, b.x, nloc, nx); b.st[0] = nloc; b.st[1] = nx; }
        const unsigned old = xb_add(&bar[XB_XSUB(b.x)], 1u);
        const unsigned gen = old / nloc;
        if (old + 1u == (gen + 1u) * nloc) {
            __builtin_amdgcn_fence(__ATOMIC_RELEASE, "agent");
            asm volatile("s_waitcnt vmcnt(0)" ::: "memory");
            const unsigned og = xb_add(&bar[XB_TOP], 1u);
            const unsigned tg = og / nx;
            if (og + 1u == (tg + 1u) * nx) xb_add(&bar[XB_TOPGEN], 1u);
            else XB_SPIN(xb_ld(&bar[XB_TOPGEN]) == tg, bar);
            __builtin_amdgcn_fence(__ATOMIC_ACQUIRE, "agent");
            xb_add(&bar[XB_XGEN(b.x)], 1u);
            asm volatile("s_waitcnt vmcnt(0)" ::: "memory");
        } else {
            XB_SPIN(xb_ld(&bar[XB_XGEN(b.x)]) == gen, bar);
            __builtin_amdgcn_fence(__ATOMIC_ACQUIRE, "agent");
            asm volatile("s_waitcnt vmcnt(0)" ::: "memory");
        }
    }
    __syncthreads();
}


__device__ __forceinline__ void stats_table(const float* Sp, int pm, LAS f32x2* tab, int tid) {
    const int row = tid >> 1, half = tid & 1;
    const float* p = Sp + ((size_t)(half * 16) * MTOK + pm * 256 + row) * 2;
    float s = 0.f, q = 0.f;
#pragma unroll
    for (int j = 0; j < 16; ++j) { const f32x2 v = *(const f32x2*)(p + (size_t)j * MTOK * 2); s += v[0]; q += v[1]; }
    s += __shfl_xor(s, 1); q += __shfl_xor(q, 1);
    const float mean = s * (1.0f / DM), var = q * (1.0f / DM) - mean * mean;
    if (half == 0) tab[row] = (f32x2){mean, 1.0f / sqrtf(var + LN_EPS)};
    __syncthreads();
}

struct Args { const float* in[18]; float* out; unsigned char* ws; int ph_lo, ph_hi; };
constexpr int LDS_BYTES = 147456;

__global__ void __launch_bounds__(512, 2) hymba_fwd(Args a) {
    extern __shared__ __attribute__((aligned(16))) unsigned char lds_raw[];
    LAS unsigned char* lds = (LAS unsigned char*)lds_raw;
    cg::grid_group grid = cg::this_grid();
    const int tid = threadIdx.x, lane = tid & 63, wave = __builtin_amdgcn_readfirstlane(tid >> 6);
    const int G = gridDim.x, c = blockIdx.x;
    const int gw = c * 8 + wave, ngw = G * 8;
    unsigned char* ws = a.ws;
    const float *x = a.in[0], *mem = a.in[1], *w_in = a.in[2], *sinks = a.in[3], *g_swa = a.in[4], *g_sb = a.in[5], *w_o = a.in[6], *ln1_g = a.in[7], *ln1_b = a.in[8],
                *w_q_mem = a.in[9], *w_kv_mem = a.in[10], *w_o_mem = a.in[11], *ln2_g = a.in[12], *ln2_b = a.in[13], *w_gate_up = a.in[14], *w_down = a.in[15], *ln3_g = a.in[16], *ln3_b = a.in[17];
    bf16_t* ALL = (bf16_t*)(ws + WS_ALL);
    bf16_t* Ob = ALL;
    bf16_t* Hb = ALL;
    bf16_t *QK = (bf16_t*)(ws + WS_QK), *VT = (bf16_t*)(ws + WS_VT), *KM = (bf16_t*)(ws + WS_KM), *VMT = (bf16_t*)(ws + WS_VMT);
    bf16_t *WoT = (bf16_t*)(ws + WS_WO), *WqmT = (bf16_t*)(ws + WS_WQM), *WomT = (bf16_t*)(ws + WS_WOM), *WguT = (bf16_t*)(ws + WS_WGU), *WdT = (bf16_t*)(ws + WS_WD);
    bf16_t *Qm = (bf16_t*)(ws + WS_QM), *Pm = (bf16_t*)(ws + WS_P), *Oc = (bf16_t*)(ws + WS_OC), *Fb = (bf16_t*)(ws + WS_F);
    bf16_t* Yb = (bf16_t*)(ws + WS_Y);
    float *SP1 = (float*)(ws + WS_SP1), *SP2 = (float*)(ws + WS_SP2);
    float *csp = (float*)(ws + WS_CSP), *csf = (float*)(ws + WS_CSF);
    const float *cs1 = csf, *bw1 = csf + NCS, *cs2 = csf + 2048, *bw2 = csf + NCS + 2048;
    LAS f32x2* tab = (LAS f32x2*)(lds + 131072 + 1024);
    float* Hf = a.out;
    const int lo = a.ph_lo, hi_ = a.ph_hi;
    volatile LAS unsigned* xst = (volatile LAS unsigned*)(lds + 131072);
    if (tid == 0) { xst[0] = 0u; xst[1] = 0u; }
    __syncthreads();
    XcdBarrier xbar; xbar.bar = (unsigned*)(ws + WS_CTL); xbar.x = 0; xbar.st = xst;
    if (hi_ - lo > 1) { xbar = xcd_barrier_post((unsigned*)(ws + WS_CTL), xst);
        grid.sync(); }
#ifdef ONLY
#define IN(k) ((k) == ONLY && lo <= (k) && (k) < hi_)
#else
#define IN(k) (lo <= (k) && (k) < hi_)
#endif
#define SEAM(k) do { if (IN(k) && IN((k) + 1)) { xcd_barrier(xbar); } } while (0)
#ifndef REPEAT
#define REPEAT (-1)
#endif
#define REP(k) for (int rep_ = 0; rep_ < ((k) == REPEAT ? 2 : 1); ++rep_, ((k) == REPEAT ? grid.sync() : (void)0))

    if (IN(0)) REP(0) {
        LAS float* scr = (LAS float*)(lds + wave * 16384);
        constexpr int I0 = 32 * 144, I1 = 32 * 128, I2 = 32 * 64, I5 = 32 * 352, I6 = 88 * 64;
        constexpr int NIT = I0 + I1 + 3 * I2 + I5 + I6;
        for (int it = gw; it < NIT; it += ngw) {
            int r = it;
            if (r < I0) { const int kb = r / 144, nb = r % 144; transpose_item(w_in, D_IN, ALL, DM, 64 * kb, 32 * nb, 18432 + 32 * nb, scr, lane); continue; } r -= I0;
            if (r < I1) { const int kb = r / 128, nb = r % 128; transpose_item(w_kv_mem, 4096, ALL, DM, 64 * kb, 32 * nb, 23040 + 32 * nb, scr, lane); continue; } r -= I1;
            if (r < I2) { const int kb = r / 64, nb = r % 64; transpose_item(w_o, DM, WoT, DM, 64 * kb, 32 * nb, 32 * nb, scr, lane); continue; } r -= I2;
            if (r < I2) { const int kb = r / 64, nb = r % 64; transpose_item_ln(w_q_mem, DM, WqmT, DM, 64 * kb, 32 * nb, 32 * nb, scr, lane, ln1_g, ln1_b, csp + (size_t)(kb * 2) * NCS + 32 * nb, csp + (size_t)(kb * 2 + 1) * NCS + 32 * nb); continue; } r -= I2;
            if (r < I2) { const int kb = r / 64, nb = r % 64; transpose_item(w_o_mem, DM, WomT, DM, 64 * kb, 32 * nb, 32 * nb, scr, lane); continue; } r -= I2;
            if (r < I5) { const int kb = r / 352, nb = r % 352; const int n0 = 32 * nb, part = n0 >= D_FF ? 1 : 0, j = n0 - part * D_FF;
                const int dr = 256 * (j >> 7) + 128 * part + (j & 127); transpose_item_ln(w_gate_up, 2 * D_FF, WguT, DM, 64 * kb, n0, dr, scr, lane, ln2_g, ln2_b, csp + (size_t)(kb * 2) * NCS + 2048 + dr, csp + (size_t)(kb * 2 + 1) * NCS + 2048 + dr); continue; } r -= I5;
            { const int kb = r / 64, nb = r % 64; transpose_item(w_down, DM, WdT, D_FF, 64 * kb, 32 * nb, 32 * nb, scr, lane); }
        }
        const size_t nx8 = (size_t)MTOK * DM / 8, nm8 = (size_t)MROWS * DM / 8;
        for (size_t i = (size_t)c * 512 + tid; i < nx8 + nm8; i += (size_t)G * 512) {
            const float* src = i < nx8 ? x + i * 8 : mem + (i - nx8) * 8;
            const f32x4 v0 = *(const f32x4*)src, v1 = *(const f32x4*)(src + 4);
            u32x4 w; w.x = cvt_pk_bf16(v0[0], v0[1]); w.y = cvt_pk_bf16(v0[2], v0[3]); w.z = cvt_pk_bf16(v1[0], v1[1]); w.w = cvt_pk_bf16(v1[2], v1[3]);
            *(u32x4*)(ALL + i * 8) = w;
        }
    }
    SEAM(0);
    if (IN(1)) REP(1) {
        pg8::SchedP1 S{(const char*)ALL, G, c};
        pg8::EpiP1 E{QK, VT, KM, VMT};
        pg8::gemm_phase<pg8::EpiP1, pg8::SchedP1, true>(lds, DM, DM, DM, S, E);
    }
    SEAM(1);
    if (IN(2)) REP(2) {
        if (G == 256) {
            const int pair = c >> 1, b = pair >> 4, h = pair & 15;
#pragma unroll 1
            for (int j = 0; j < 4; ++j) {
                const int qb = (c & 1) ? (j == 0 ? 1 : (j == 1 ? 6 : (j == 2 ? 3 : 4))) : (j == 0 ? 0 : (j == 1 ? 7 : (j == 2 ? 2 : 5)));
                const int w = (j & 1) ? 7 - wave : wave;
                sb_wave(QK, VT, Ob, g_sb, b, h, 256 * qb + 32 * w, lane, lds + wave * 16384);
            }
        } else {
            for (int u = gw; u < NB * 16 * 64; u += ngw) sb_wave(QK, VT, Ob, g_sb, u >> 10, (u >> 6) & 15, 32 * (u & 63), lane, lds + wave * 16384);
        }
        for (int u = gw; u < NB * 16 * 64; u += ngw) swa_wave(QK, VT, Ob, g_swa, sinks, u >> 10, (u >> 6) & 15, 32 * (u & 63), lane, lds + wave * 16384);
    }
    SEAM(2);
    if (IN(3)) {
        for (int i = c * 512 + tid; i < 2 * NCS; i += G * 512) { float acc_ = 0.f;
#pragma unroll 8
            for (int kb = 0; kb < 32; ++kb) acc_ += csp[(size_t)kb * 2 * NCS + i];
            csf[i] = acc_; }
    }
    if (IN(3)) {
        pg8::SchedPlain S; S.init(Ob, DM, WoT, DM, MTOK, DM, G, c);
        pg8::EpiRes<0> E{x, Yb, nullptr, nullptr, nullptr, SP1};
        pg8::gemm_phase<pg8::EpiRes<0>, pg8::SchedPlain, true>(lds, DM, DM, DM, S, E);
    }
    SEAM(3);
    if (IN(5)) {
        pg8::SchedPlain S; S.init(Yb, DM, WqmT, DM, MTOK, DM, G, c);
        { pg8::Unit u0; int pm0 = 0; if (S.next(0, u0)) pm0 = u0.pm; stats_table(SP1, pm0, tab, tid); }
        pg8::EpiLnPlain E{Qm, DM, tab, cs1, bw1};
        pg8::gemm_phase<pg8::EpiLnPlain, pg8::SchedPlain, true>(lds, DM, DM, DM, S, E);
    }
    SEAM(5);
    if (IN(6)) {
        pg8::SchedQK S{(const char*)Qm, (const char*)KM, G, c};
        pg8::EpiSoftmax E{Pm};
        pg8::gemm_phase<pg8::EpiSoftmax, pg8::SchedQK, false>(lds, DM, DM, 512, S, E);
    }
    SEAM(6);
    if (IN(7)) {
        pg8::SchedPV S{(const char*)Pm, (const char*)VMT, G, c};
        pg8::EpiPV E{Oc};
        pg8::gemm_phase<pg8::EpiPV, pg8::SchedPV, true>(lds, MEML, MROWS, MEML, S, E);
    }
    SEAM(7);
    if (IN(8)) {
        pg8::SchedPlain S; S.init(Oc, DM, WomT, DM, MTOK, DM, G, c);
        { pg8::Unit u0; int pm0 = 0; if (S.next(0, u0)) pm0 = u0.pm; stats_table(SP1, pm0, tab, tid); }
        pg8::EpiRes<1> E{nullptr, Yb, tab, ln1_g, ln1_b, SP2};
        pg8::gemm_phase<pg8::EpiRes<1>, pg8::SchedPlain, true>(lds, DM, DM, DM, S, E);
    }
    SEAM(8);
    if (IN(10)) {
        pg8::SchedPlain S; S.init(Yb, DM, WguT, DM, MTOK, 2 * D_FF, G, c);
        { pg8::Unit u0; int pm0 = 0; if (S.next(0, u0)) pm0 = u0.pm; stats_table(SP2, pm0, tab, tid); }
        pg8::EpiSwiglu E{Fb, tab, cs2, bw2};
        pg8::gemm_phase<pg8::EpiSwiglu, pg8::SchedPlain, true>(lds, DM, DM, DM, S, E);
    }
    SEAM(10);
    if (IN(11)) {
        pg8::SchedPlain S; S.init(Fb, D_FF, WdT, D_FF, MTOK, DM, G, c);
        { pg8::Unit u0; int pm0 = 0; if (S.next(0, u0)) pm0 = u0.pm; stats_table(SP2, pm0, tab, tid); }
        pg8::EpiRes<2> E{nullptr, Yb, tab, ln2_g, ln2_b, nullptr};
        pg8::gemm_phase<pg8::EpiRes<2>, pg8::SchedPlain, true>(lds, D_FF, D_FF, D_FF, S, E);
    }
    SEAM(11);
    if (IN(12)) ln_rows(Yb, ln3_g, ln3_b, a.out, nullptr, gw, ngw, lane);
#undef IN
#undef SEAM
}

extern "C" void kernel_launch(void* const* d_in, const int* in_sizes, int n_in, void* d_out, int out_size, void* d_ws, size_t ws_size, hipStream_t stream) {
    static int grid = 0;
    if (grid == 0) {
        if (n_in != 18 || in_sizes[0] != MTOK * DM || out_size != MTOK * DM || ws_size < WS_END) {
            fprintf(stderr, "kernel_launch: unexpected shapes / workspace (n_in %d, in0 %d, out %d, ws %zu, need %zu); nothing launched\n", n_in, n_in > 0 ? in_sizes[0] : -1, out_size, ws_size, (size_t)WS_END);
            grid = -1; return; }
        int dev = 0, cus = 0, per_cu = 0;
        hipGetDevice(&dev);
        hipDeviceGetAttribute(&cus, hipDeviceAttributeMultiprocessorCount, dev);
        hipFuncSetAttribute((const void*)hymba_fwd, hipFuncAttributeMaxDynamicSharedMemorySize, LDS_BYTES);
        hipOccupancyMaxActiveBlocksPerMultiprocessor(&per_cu, (const void*)hymba_fwd, 512, LDS_BYTES);
        if (per_cu < 1) { fprintf(stderr, "kernel_launch: occupancy query says %d blocks per CU\n", per_cu); per_cu = 1; }
        grid = cus * 1;
        if (grid != 256) fprintf(stderr, "kernel_launch: %d CUs; P6 needs >= 256 workgroups\n", grid);
    }
    if (grid < 0) return;
    Args a{};
    for (int i = 0; i < 18; ++i) a.in[i] = (const float*)d_in[i];
    a.out = (float*)d_out; a.ws = (unsigned char*)d_ws;
#if MK_MULTI
    for (int p = 0; p < NPHASE; ++p) { a.ph_lo = p; a.ph_hi = p + 1;
        for (int rep = 0; rep < ((PROBE_DUP >> p) & 1 ? 2 : 1); ++rep) hipLaunchKernelGGL(hymba_fwd, dim3(grid), dim3(512), LDS_BYTES, stream, a); }
#else
    a.ph_lo = 0; a.ph_hi = NPHASE;
    (void)hipMemsetAsync((char*)d_ws + WS_CTL, 0, CTL_BYTES, stream);
    void* args[] = {&a};
    hipError_t e = hipLaunchCooperativeKernel((const void*)hymba_fwd, dim3(grid), dim3(512), args, LDS_BYTES, stream);
    if (e != hipSuccess) fprintf(stderr, "cooperative launch failed: %s (grid %d)\n", hipGetErrorString(e), grid);
#endif
}
```

```cpp
#include <hip/hip_runtime.h>
#include <hip/hip_cooperative_groups.h>
#include <cstdio>
#include <cstdint>
namespace cg = cooperative_groups;

#ifndef PROBE_DUP
#define PROBE_DUP 0
#endif
#ifndef MK_MULTI
#define MK_MULTI 0
#endif

#define LAS __attribute__((address_space(3)))
typedef unsigned short bf16_t;
typedef short bf16x8 __attribute__((ext_vector_type(8)));
typedef short s16x4 __attribute__((ext_vector_type(4)));
typedef float f32x4 __attribute__((ext_vector_type(4)));
typedef float f32x2 __attribute__((ext_vector_type(2)));
typedef float f32x16 __attribute__((ext_vector_type(16)));
typedef unsigned u32x4 __attribute__((ext_vector_type(4)));
typedef unsigned u32x2 __attribute__((ext_vector_type(2)));

constexpr int DM = 2048, NB = 8, SEQ = 2048, MTOK = NB * SEQ;
constexpr int MEML = 256, MROWS = NB * MEML;
constexpr int D_IN = 4608, D_FF = 5632, NQK = 3328, NVT = 1280;
constexpr float ALPHA = 1.189207115002721f;
constexpr float LN_EPS = 1e-5f, RMS_EPS = 1e-6f;
constexpr float LOG2E = 1.4426950408889634f;
constexpr int NPHASE = 13, NCS = 2048 + 11264;

constexpr size_t MiB = 1u << 20;
constexpr size_t WS_QK = 0;
constexpr size_t WS_VT = 104 * MiB;
constexpr size_t WS_QM = 0;
constexpr size_t WS_P = 64 * MiB;
constexpr size_t WS_OC = 96 * MiB;
constexpr size_t WS_F = 0;
constexpr size_t WS_Y = 176 * MiB;
constexpr size_t WS_ALL = 304 * MiB;
constexpr size_t WS_KM = 160 * MiB;
constexpr size_t WS_VMT = 168 * MiB;
constexpr size_t WS_WO = 410 * MiB, WS_WQM = 418 * MiB, WS_WOM = 426 * MiB;
constexpr size_t WS_WGU = 434 * MiB;
constexpr size_t WS_WD = 478 * MiB;
constexpr size_t WS_CTL = 500 * MiB, CTL_BYTES = 64 * 1024;
constexpr size_t WS_CSP = 501 * MiB;
constexpr size_t WS_CSF = 505 * MiB;
constexpr size_t WS_SP1 = 368 * MiB, WS_SP2 = 372 * MiB;
constexpr size_t WS_END = 506 * MiB;

typedef __bf16 bf16x2_t __attribute__((ext_vector_type(2)));
__device__ __forceinline__ unsigned cvt_pk_bf16(float lo, float hi) { const f32x2 v = {lo, hi}; const bf16x2_t b = __builtin_convertvector(v, bf16x2_t); return __builtin_bit_cast(unsigned, b); }
__device__ __forceinline__ float fexp2(float x) { return __builtin_amdgcn_exp2f(x); }
__device__ __forceinline__ float flog2(float x) { return __builtin_amdgcn_logf(x); }
__device__ __forceinline__ float wave_sum(float v) {
#pragma unroll
    for (int o = 1; o < 64; o <<= 1) v += __shfl_xor(v, o);
    return v;
}
#define LDS_WAIT() asm volatile("s_waitcnt lgkmcnt(0)" ::: "memory")

namespace pg8 {
constexpr int BM = 256, BK = 64, HALF = 128, HTB = HALF * BK * 2, STAGE_BYTES = 8 * HTB, NXCD = 8, WGM = 8;
__host__ __device__ __forceinline__ int lds_byte(int r, int c) { const int st = (r >> 4) * 2 + (c >> 5), rr = r & 15, cc = c & 31, ob = rr * 64 + cc * 2; return st * 1024 + (ob ^ (((ob >> 9) & 1) << 5)); }
__host__ __device__ __forceinline__ void stage_rc(int b, int& R, int& C) { const int st = b / 1024, sb = b % 1024, swz = sb ^ (((sb >> 9) & 1) << 5); R = (st >> 1) * 16 + swz / 64; C = (st & 1) * 32 + (swz % 64) / 2; }
__host__ __device__ __forceinline__ int perm32(int rho) { const int n = rho >> 4, i = rho & 15; return 8 * (i >> 2) + 4 * n + (i & 3); }

struct Unit { int pm, pn, z; };

__device__ __forceinline__ void map_tile(int l, int nM, int nN, int& pm, int& pn) {
    const int nwg = nM * nN; int wgid = l;
    { const int q = nwg / NXCD, r = nwg % NXCD, xcd = wgid % NXCD, off = wgid / NXCD; wgid = (xcd < r ? xcd * (q + 1) : r * (q + 1) + (xcd - r) * q) + off; }
    const int nig = WGM * nN, gid = wgid / nig, fm = gid * WGM, gsz = (nM - fm) < WGM ? (nM - fm) : WGM;
    pm = fm + ((wgid % nig) % gsz); pn = (wgid % nig) / gsz;
}

struct SchedPlain {
    const char* A; const char* Bt; int nM, nN, G, c; size_t tA, tB;
    __device__ void init(const bf16_t* A_, int lda, const bf16_t* B_, int ldb, int M, int N, int G_, int c_) { A = (const char*)A_; Bt = (const char*)B_; nM = M / BM; nN = N / BM; G = G_; c = c_; tA = (size_t)BM * lda * 2; tB = (size_t)BM * ldb * 2; }
    __device__ __forceinline__ bool next(int i, Unit& u) const { const long L = (long)i * G + c; if (L >= (long)nM * nN) return false; map_tile((int)L, nM, nN, u.pm, u.pn); u.z = 0; return true; }
    __device__ __forceinline__ const char* pa(const Unit& u) const { return A + (size_t)u.pm * tA; }
    __device__ __forceinline__ const char* pb(const Unit& u) const { return Bt + (size_t)u.pn * tB; }
};

struct SchedP1 {
    const char* all; int G, c;
    static constexpr size_t TB = (size_t)BM * DM * 2;
    __device__ __forceinline__ bool next(int i, Unit& u) const {
        const long L = (long)i * G + c; if (L >= 1280) return false;
        int l = (int)L;
        if (l < 832) { u.z = 0; map_tile(l, 64, 13, u.pm, u.pn); }
        else if (l < 1152) { u.z = 1; map_tile(l - 832, 5, 64, u.pm, u.pn); }
        else if (l < 1216) { u.z = 2; map_tile(l - 1152, 8, 8, u.pm, u.pn); }
        else { u.z = 3; map_tile(l - 1216, 8, 8, u.pm, u.pn); }
        return true;
    }
    __device__ __forceinline__ const char* pa(const Unit& u) const {
        const int t = u.z == 0 ? u.pm : (u.z == 1 ? 72 + (u.pm == 0 ? 5 : 13 + u.pm) : (u.z == 2 ? 64 + u.pm : 98 + u.pm));
        return all + (size_t)t * TB;
    }
    __device__ __forceinline__ const char* pb(const Unit& u) const {
        const int t = u.z == 0 ? 72 + (u.pn < 5 ? u.pn : u.pn + 1) : (u.z == 1 ? u.pn : (u.z == 2 ? 90 + u.pn : 64 + u.pn));
        return all + (size_t)t * TB;
    }
};

struct SchedQK {
    const char* Qm; const char* Km; int G, c;
    __device__ __forceinline__ bool next(int i, Unit& u) const { const long L = (long)i * G + c; if (L >= 256) return false; u.z = (int)L >> 3; u.pm = (int)L & 7; u.pn = 0; return true; }
    __device__ __forceinline__ const char* pa(const Unit& u) const { const int b = u.z >> 2, h = u.z & 3; return Qm + ((size_t)(b * SEQ + u.pm * 256) * DM + h * 512) * 2; }
    __device__ __forceinline__ const char* pb(const Unit& u) const { const int b = u.z >> 2, h = u.z & 3; return Km + ((size_t)(b * MEML) * DM + h * 512) * 2; }
};
struct SchedPV {
    const char* P; const char* Vt; int G, c;
    __device__ __forceinline__ bool next(int i, Unit& u) const { const long L = (long)i * G + c; if (L >= 512) return false; u.z = (int)L >> 4; u.pm = ((int)L >> 1) & 7; u.pn = (int)L & 1; return true; }
    __device__ __forceinline__ const char* pa(const Unit& u) const { return P + ((size_t)u.z * SEQ + u.pm * 256) * MEML * 2; }
    __device__ __forceinline__ const char* pb(const Unit& u) const { const int b = u.z >> 2, h = u.z & 3; return Vt + ((size_t)(h * 512 + u.pn * 256) * MROWS + b * MEML) * 2; }
};

typedef f32x4 Acc[2][2][4][2];
__device__ __forceinline__ void store_tile_bf16(const Acc& acc, bf16_t* base, size_t ldc, int wr, int wc, int fr, int fq) {
    bf16_t* p0 = base + (size_t)(wr * 64 + fr) * ldc + wc * 32 + 8 * fq;
#pragma unroll
    for (int ai = 0; ai < 2; ++ai)
#pragma unroll
        for (int m = 0; m < 4; ++m) { bf16_t* rowp = p0 + (size_t)(ai * HALF + m * 16) * ldc;
#pragma unroll
            for (int bj = 0; bj < 2; ++bj) { const f32x4 v0 = acc[ai][bj][m][0], v1 = acc[ai][bj][m][1]; u32x4 w;
                w.x = cvt_pk_bf16(v0[0], v0[1]); w.y = cvt_pk_bf16(v0[2], v0[3]); w.z = cvt_pk_bf16(v1[0], v1[1]); w.w = cvt_pk_bf16(v1[2], v1[3]);
                *(u32x4*)(rowp + bj * HALF) = w; } }
}
struct EpiP1 {
    static constexpr bool PERM = true, AFTER_DRAIN = false;
    bf16_t *QK, *VT, *KM, *VMT;
    __device__ __forceinline__ void operator()(const Acc& acc, const Unit& u, int wr, int wc, int fr, int fq) const {
        if (u.z == 0) {
            const int b = u.pm >> 3, hs0 = 4 * u.pn + (wc >> 1), hi = wc & 1;
#pragma unroll
            for (int ai = 0; ai < 2; ++ai)
#pragma unroll
                for (int m = 0; m < 4; ++m) { const int t = (u.pm & 7) * 256 + ai * HALF + wr * 64 + m * 16 + fr;
#pragma unroll
                    for (int bj = 0; bj < 2; ++bj) { const f32x4 v0 = acc[ai][bj][m][0], v1 = acc[ai][bj][m][1]; u32x4 w;
                        w.x = cvt_pk_bf16(v0[0], v0[1]); w.y = cvt_pk_bf16(v0[2], v0[3]); w.z = cvt_pk_bf16(v1[0], v1[1]); w.w = cvt_pk_bf16(v1[2], v1[3]);
                        const size_t off = ((((size_t)(b * 52 + hs0 + 2 * bj) * 64 + (t >> 5)) * 4 + fq) * 64 + hi * 32 + (t & 31)) * 8;
                        *(u32x4*)(QK + off) = w; } }
        } else if (u.z == 1) {
            const int b = u.pn >> 3, s = fq >> 1, half = fq & 1;
#pragma unroll
            for (int ai = 0; ai < 2; ++ai)
#pragma unroll
                for (int m = 0; m < 4; ++m) { const int vrow = u.pm * 256 + ai * HALF + wr * 64 + m * 16 + fr, vh = vrow >> 6, db = (vrow >> 5) & 1, dl = vrow & 31;
#pragma unroll
                    for (int bj = 0; bj < 2; ++bj) { const int blk = 8 * (u.pn & 7) + 4 * bj + wc;
                        const size_t off = ((((size_t)(b * 20 + vh) * 64 + blk) * 4 + db * 2 + s) * 64 + dl) * 8 + 4 * half;
#pragma unroll
                        for (int n = 0; n < 2; ++n) { const f32x4 v = acc[ai][bj][m][n]; u32x2 w; w.x = cvt_pk_bf16(v[0], v[1]); w.y = cvt_pk_bf16(v[2], v[3]);
                            *(u32x2*)(VT + off + n * 256) = w; } } }
        } else {
            bf16_t* base; size_t ldc;
            if (u.z == 2) { ldc = DM; base = KM + (size_t)(u.pm * 256) * ldc + u.pn * 256; }
            else { ldc = MROWS; base = VMT + (size_t)(u.pm * 256) * ldc + u.pn * 256; }
            store_tile_bf16(acc, base, ldc, wr, wc, fr, fq);
        }
    }
};
struct EpiPlain {
    static constexpr bool PERM = true, AFTER_DRAIN = false;
    bf16_t* O; int ldc;
    __device__ __forceinline__ void operator()(const Acc& acc, const Unit& u, int wr, int wc, int fr, int fq) const {
        store_tile_bf16(acc, O + (size_t)(u.pm * 256) * ldc + u.pn * 256, ldc, wr, wc, fr, fq);
    }
};
struct EpiPV {
    static constexpr bool PERM = true, AFTER_DRAIN = false;
    bf16_t* O;
    __device__ __forceinline__ void operator()(const Acc& acc, const Unit& u, int wr, int wc, int fr, int fq) const {
        const int b = u.z >> 2, h = u.z & 3;
        store_tile_bf16(acc, O + (size_t)(b * SEQ + u.pm * 256) * DM + h * 512 + u.pn * 256, DM, wr, wc, fr, fq);
    }
};
__device__ __forceinline__ void row_stats(const LAS f32x2* tab, int trow, float& mean, float& rstd) { const f32x2 s = tab[trow]; mean = s[0]; rstd = s[1]; }
struct EpiLnPlain {
    static constexpr bool PERM = true, AFTER_DRAIN = false;
    bf16_t* O; int ldc; const LAS f32x2* S; const float* cs; const float* bw;
    __device__ __forceinline__ void operator()(const Acc& acc, const Unit& u, int wr, int wc, int fr, int fq) const {
        const int colt = u.pn * 256 + wc * 32 + 8 * fq;
        bf16_t* p0 = O + (size_t)(u.pm * 256 + wr * 64 + fr) * ldc + colt;
#pragma unroll
        for (int ai = 0; ai < 2; ++ai)
#pragma unroll
            for (int m = 0; m < 4; ++m) { float mean, rstd; row_stats(S, ai * HALF + wr * 64 + m * 16 + fr, mean, rstd);
                bf16_t* rowp = p0 + (size_t)(ai * HALF + m * 16) * ldc;
#pragma unroll
                for (int bj = 0; bj < 2; ++bj) { const int col = colt + bj * HALF;
                    const f32x4 c0 = *(const f32x4*)(cs + col), c1 = *(const f32x4*)(cs + col + 4), b0 = *(const f32x4*)(bw + col), b1 = *(const f32x4*)(bw + col + 4);
                    const f32x4 v0 = (acc[ai][bj][m][0] - c0 * mean) * rstd + b0, v1 = (acc[ai][bj][m][1] - c1 * mean) * rstd + b1; u32x4 w;
                    w.x = cvt_pk_bf16(v0[0], v0[1]); w.y = cvt_pk_bf16(v0[2], v0[3]); w.z = cvt_pk_bf16(v1[0], v1[1]); w.w = cvt_pk_bf16(v1[2], v1[3]);
                    *(u32x4*)(rowp + bj * HALF) = w; } }
    }
};
template <int MODE> struct EpiRes {
    static constexpr bool PERM = true, AFTER_DRAIN = false;
    const bf16_t* Xb; bf16_t* Yb; const LAS f32x2* Sin; const float* g; const float* b; float* Sout;
    __device__ __forceinline__ void operator()(const Acc& acc, const Unit& u, int wr, int wc, int fr, int fq) const {
        const int col0 = u.pn * 256 + wc * 32 + 8 * fq;
#pragma unroll
        for (int ai = 0; ai < 2; ++ai)
#pragma unroll
            for (int m = 0; m < 4; ++m) { const int trow = ai * HALF + wr * 64 + m * 16 + fr, row = u.pm * 256 + trow; const size_t off = (size_t)row * DM + col0;
                float mean = 0.f, rstd = 1.f; if (MODE > 0) row_stats(Sin, trow, mean, rstd);
                f32x4 rv[2][2];
#pragma unroll
                for (int bj = 0; bj < 2; ++bj) { const int dc = bj * HALF;
                    { const u32x4 w = *(const u32x4*)((MODE == 0 ? Xb : Yb) + off + dc);
                        const f32x4 y0 = {__builtin_bit_cast(float, w.x << 16), __builtin_bit_cast(float, w.x & 0xffff0000u), __builtin_bit_cast(float, w.y << 16), __builtin_bit_cast(float, w.y & 0xffff0000u)};
                        const f32x4 y1 = {__builtin_bit_cast(float, w.z << 16), __builtin_bit_cast(float, w.z & 0xffff0000u), __builtin_bit_cast(float, w.w << 16), __builtin_bit_cast(float, w.w & 0xffff0000u)};
                        if (MODE == 0) { rv[bj][0] = y0; rv[bj][1] = y1; }
                        else { rv[bj][0] = (y0 - mean) * rstd * *(const f32x4*)(g + col0 + dc) + *(const f32x4*)(b + col0 + dc);
                            rv[bj][1] = (y1 - mean) * rstd * *(const f32x4*)(g + col0 + dc + 4) + *(const f32x4*)(b + col0 + dc + 4); } } }
                float ps = 0.f, pq = 0.f;
#pragma unroll
                for (int bj = 0; bj < 2; ++bj) { const f32x4 y0 = rv[bj][0] * ALPHA + acc[ai][bj][m][0], y1 = rv[bj][1] * ALPHA + acc[ai][bj][m][1]; u32x4 w;
                    w.x = cvt_pk_bf16(y0[0], y0[1]); w.y = cvt_pk_bf16(y0[2], y0[3]); w.z = cvt_pk_bf16(y1[0], y1[1]); w.w = cvt_pk_bf16(y1[2], y1[3]);
                    *(u32x4*)(Yb + off + bj * HALF) = w;
                    if (MODE < 2) { ps += ((y0[0] + y0[1]) + (y0[2] + y0[3])) + ((y1[0] + y1[1]) + (y1[2] + y1[3]));
                        pq += ((y0[0] * y0[0] + y0[1] * y0[1]) + (y0[2] * y0[2] + y0[3] * y0[3])) + ((y1[0] * y1[0] + y1[1] * y1[1]) + (y1[2] * y1[2] + y1[3] * y1[3])); } }
                if (MODE < 2) { ps += __shfl_xor(ps, 16); ps += __shfl_xor(ps, 32); pq += __shfl_xor(pq, 16); pq += __shfl_xor(pq, 32);
                    if (fq == 0) *(f32x2*)(Sout + ((size_t)(4 * u.pn + wc) * MTOK + row) * 2) = (f32x2){ps, pq}; }
            }
    }
};
struct EpiSwiglu {
    static constexpr bool PERM = true, AFTER_DRAIN = false;
    bf16_t* F; const LAS f32x2* S; const float* cs; const float* bw;
    __device__ __forceinline__ void operator()(const Acc& acc, const Unit& u, int wr, int wc, int fr, int fq) const {
        bf16_t* p0 = F + (size_t)(u.pm * 256 + wr * 64 + fr) * D_FF + u.pn * 128 + wc * 32 + 8 * fq;
        const int colt = u.pn * 256 + wc * 32 + 8 * fq;
        f32x4 cg[2], cu[2], bg[2], bu[2];
#pragma unroll
        for (int n = 0; n < 2; ++n) { cg[n] = *(const f32x4*)(cs + colt + 4 * n); cu[n] = *(const f32x4*)(cs + colt + HALF + 4 * n); bg[n] = *(const f32x4*)(bw + colt + 4 * n); bu[n] = *(const f32x4*)(bw + colt + HALF + 4 * n); }
#pragma unroll
        for (int ai = 0; ai < 2; ++ai)
#pragma unroll
            for (int m = 0; m < 4; ++m) { float mean, rstd; row_stats(S, ai * HALF + wr * 64 + m * 16 + fr, mean, rstd); float o[8];
#pragma unroll
                for (int n = 0; n < 2; ++n) { const f32x4 gv = (acc[ai][0][m][n] - cg[n] * mean) * rstd + bg[n], uv = (acc[ai][1][m][n] - cu[n] * mean) * rstd + bu[n];
#pragma unroll
                    for (int j = 0; j < 4; ++j) o[n * 4 + j] = gv[j] * __builtin_amdgcn_rcpf(1.0f + fexp2(-gv[j] * LOG2E)) * uv[j]; }
                u32x4 w; w.x = cvt_pk_bf16(o[0], o[1]); w.y = cvt_pk_bf16(o[2], o[3]); w.z = cvt_pk_bf16(o[4], o[5]); w.w = cvt_pk_bf16(o[6], o[7]);
                *(u32x4*)(p0 + (size_t)(ai * HALF + m * 16) * D_FF) = w; }
    }
};
struct EpiSoftmax {
    static constexpr bool PERM = true, AFTER_DRAIN = true;
    bf16_t* P;
    __device__ __forceinline__ void fused(Acc& acc, const Unit& u, int wr, int wc, int fr, int fq, LAS unsigned char* lds, int wid, int lane) const {
        const float c = 0.04419417382415922f * LOG2E;
        LAS f32x2* T = (LAS f32x2*)lds;
        float mw[2][4];
#pragma unroll
        for (int ai = 0; ai < 2; ++ai)
#pragma unroll
            for (int m = 0; m < 4; ++m) {
                float mx = -INFINITY;
#pragma unroll
                for (int bj = 0; bj < 2; ++bj)
#pragma unroll
                    for (int n = 0; n < 2; ++n) { const f32x4 x = acc[ai][bj][m][n]; mx = fmaxf(mx, fmaxf(fmaxf(x[0], x[1]), fmaxf(x[2], x[3]))); }
                mx = fmaxf(mx, __shfl_xor(mx, 16)); mx = fmaxf(mx, __shfl_xor(mx, 32));
                float s = 0.f;
#pragma unroll
                for (int bj = 0; bj < 2; ++bj)
#pragma unroll
                    for (int n = 0; n < 2; ++n) { f32x4 x = acc[ai][bj][m][n];
#pragma unroll
                        for (int j = 0; j < 4; ++j) { x[j] = fexp2((x[j] - mx) * c); s += x[j]; }
                        acc[ai][bj][m][n] = x; }
                s += __shfl_xor(s, 16); s += __shfl_xor(s, 32);
                mw[ai][m] = mx;
                if (fq == 0) T[(ai * HALF + wr * 64 + m * 16 + fr) * 4 + wc] = (f32x2){mx, s};
            }
        LDS_WAIT(); __builtin_amdgcn_s_barrier(); asm volatile("" ::: "memory");
        bf16_t* p0 = P + ((size_t)u.z * SEQ + u.pm * 256 + wr * 64 + fr) * MEML + wc * 32 + 8 * fq;
#pragma unroll
        for (int ai = 0; ai < 2; ++ai)
#pragma unroll
            for (int m = 0; m < 4; ++m) { const int row = ai * HALF + wr * 64 + m * 16 + fr;
                const f32x2 t0 = T[row * 4 + 0], t1 = T[row * 4 + 1], t2 = T[row * 4 + 2], t3 = T[row * 4 + 3];
                const float M = fmaxf(fmaxf(t0.x, t1.x), fmaxf(t2.x, t3.x));
                const float tot = t0.y * fexp2((t0.x - M) * c) + t1.y * fexp2((t1.x - M) * c) + t2.y * fexp2((t2.x - M) * c) + t3.y * fexp2((t3.x - M) * c);
                const float f = fexp2((mw[ai][m] - M) * c) / tot;
                bf16_t* rowp = p0 + (size_t)(ai * HALF + m * 16) * MEML;
#pragma unroll
                for (int bj = 0; bj < 2; ++bj) { const f32x4 v0 = acc[ai][bj][m][0] * f, v1 = acc[ai][bj][m][1] * f; u32x4 w;
                    w.x = cvt_pk_bf16(v0[0], v0[1]); w.y = cvt_pk_bf16(v0[2], v0[3]); w.z = cvt_pk_bf16(v1[0], v1[1]); w.w = cvt_pk_bf16(v1[2], v1[3]);
                    *(u32x4*)(rowp + bj * HALF) = w; } }
    }
};

template <class Epi, class Sched, bool ALIGN_EPI>
__device__ __forceinline__ void gemm_phase(LAS unsigned char* lds, const int lda, const int ldb, const int K, const Sched& S, const Epi& E) {
    const int tid = threadIdx.x, wid = __builtin_amdgcn_readfirstlane(tid >> 6), lane = tid & 63, wr = wid >> 2, wc = wid & 3, fr = lane & 15, fq = lane >> 4;
    const int nt = K / BK;
    unsigned voffA[2], voffB[2];
#pragma unroll
    for (int i = 0; i < 2; ++i) { int R, C; stage_rc(tid * 16 + i * 8192, R, C); const int Rb = Epi::PERM ? ((R & ~31) + perm32(R & 31)) : R;
        voffA[i] = (unsigned)(R * lda + C) * 2u; voffB[i] = (unsigned)(Rb * ldb + C) * 2u; }
    const size_t kstep = (size_t)(BK * 2);
    const size_t hsA = (size_t)HALF * lda * 2, hsB = (size_t)HALF * ldb * 2;
    const unsigned ldsw = (unsigned)wid * 1024u;
    const int aoff = lds_byte(wr * 64 + fr, fq * 8), boff = lds_byte(wc * 32 + fr, fq * 8);
#define PG8_SA(b, h) (((b) * 2 + (h)) * HTB)
#define PG8_SB(b, h) ((4 + (b) * 2 + (h)) * HTB)
#define PG8_STAGE(bufoff, gbase, voff) do { _Pragma("unroll") for (int _i = 0; _i < 2; ++_i) \
        __builtin_amdgcn_global_load_lds((const unsigned*)((const char*)(gbase) + (voff)[_i]), (LAS unsigned*)(lds + (bufoff) + ldsw + _i * 8192), 16, 0, 0); } while (0)
#define PG8_LDA(dst, b, h) do { _Pragma("unroll") for (int m = 0; m < 4; ++m) _Pragma("unroll") for (int k = 0; k < 2; ++k) dst[m][k] = *(const LAS bf16x8*)(lds + PG8_SA(b, h) + aoff + m * 2048 + k * 1024); } while (0)
#define PG8_LDB(dst, b, h) do { _Pragma("unroll") for (int n = 0; n < 2; ++n) _Pragma("unroll") for (int k = 0; k < 2; ++k) dst[n][k] = *(const LAS bf16x8*)(lds + PG8_SB(b, h) + boff + n * 2048 + k * 1024); } while (0)
#define PG8_MMA(ai, bj, At, Bt) do { __builtin_amdgcn_s_setprio(1); _Pragma("unroll") for (int m = 0; m < 4; ++m) _Pragma("unroll") for (int n = 0; n < 2; ++n) _Pragma("unroll") for (int k = 0; k < 2; ++k) \
        acc[ai][bj][m][n] = __builtin_amdgcn_mfma_f32_16x16x32_bf16(Bt[n][k], At[m][k], acc[ai][bj][m][n], 0, 0, 0); __builtin_amdgcn_s_setprio(0); } while (0)
#define PG8_WAIT_V(n) asm volatile("s_waitcnt vmcnt(" #n ")" ::: "memory")
#define PG8_WAIT_L(n) asm volatile("s_waitcnt lgkmcnt(" #n ")" ::: "memory")
#define PG8_BAR __builtin_amdgcn_s_barrier()
#define PG8_SCHED __builtin_amdgcn_sched_barrier(0)
    Unit cur, nxt; int ui = 0;
    if (!S.next(0, cur)) return;
    Acc acc;
#pragma unroll
    for (int a = 0; a < 2; ++a)
#pragma unroll
        for (int b = 0; b < 2; ++b)
#pragma unroll
            for (int m = 0; m < 4; ++m)
#pragma unroll
                for (int n = 0; n < 2; ++n) acc[a][b][m][n] = (f32x4){0.f, 0.f, 0.f, 0.f};
    bf16x8 At[4][2], B0[2][2], B1[2][2];
    const char* cA = S.pa(cur); const char* cB = S.pb(cur);
    PG8_STAGE(PG8_SB(0, 0), cB, voffB); PG8_STAGE(PG8_SB(0, 1), cB + hsB, voffB); PG8_STAGE(PG8_SA(0, 0), cA, voffA); PG8_STAGE(PG8_SA(0, 1), cA + hsA, voffA);
    if (wr == 1) PG8_BAR;
    PG8_WAIT_V(2); PG8_BAR;
    PG8_STAGE(PG8_SB(1, 0), cB + kstep, voffB); PG8_STAGE(PG8_SA(1, 0), cA + kstep, voffA); PG8_STAGE(PG8_SB(1, 1), cB + hsB + kstep, voffB);
    PG8_WAIT_V(6); PG8_BAR;
    for (;;) {
        const bool has_next = S.next(ui + 1, nxt);
        const char* nA = has_next ? S.pa(nxt) : cA; const char* nB = has_next ? S.pb(nxt) : cB;
#pragma unroll 1
        for (int t = 0; t < nt; t += 2) {
            const bool last = (t == nt - 2);
            const char* a1 = cA + (size_t)(t + 1) * kstep;
            const char* a2 = last ? nA : cA + (size_t)(t + 2) * kstep; const char* b2 = last ? nB : cB + (size_t)(t + 2) * kstep;
            const char* a3 = a2 + kstep; const char* b3 = b2 + kstep;
            PG8_LDB(B0, 0, 0); PG8_LDB(B1, 0, 1); PG8_SCHED; PG8_LDA(At, 0, 0); PG8_STAGE(PG8_SA(1, 1), a1 + hsA, voffA);
            PG8_WAIT_V(8); PG8_WAIT_L(0); PG8_BAR; PG8_MMA(0, 0, At, B0); PG8_MMA(0, 1, At, B1); PG8_BAR; PG8_SCHED;
            PG8_LDA(At, 0, 1); PG8_STAGE(PG8_SB(0, 0), b2, voffB); PG8_STAGE(PG8_SB(0, 1), b2 + hsB, voffB); PG8_STAGE(PG8_SA(0, 0), a2, voffA);
            PG8_WAIT_V(8); PG8_WAIT_L(0); PG8_BAR; PG8_MMA(1, 0, At, B0); PG8_MMA(1, 1, At, B1); PG8_BAR; PG8_SCHED;
            PG8_LDB(B0, 1, 0); PG8_LDB(B1, 1, 1); PG8_SCHED; PG8_LDA(At, 1, 0); PG8_STAGE(PG8_SA(0, 1), a2 + hsA, voffA);
            PG8_WAIT_V(8); PG8_WAIT_L(0); PG8_BAR; PG8_MMA(0, 0, At, B0); PG8_MMA(0, 1, At, B1); PG8_BAR; PG8_SCHED;
            PG8_LDA(At, 1, 1); PG8_STAGE(PG8_SB(1, 0), b3, voffB); PG8_STAGE(PG8_SB(1, 1), b3 + hsB, voffB); PG8_STAGE(PG8_SA(1, 0), a3, voffA);
            PG8_WAIT_V(8); PG8_WAIT_L(0); PG8_BAR; PG8_MMA(1, 0, At, B0); PG8_MMA(1, 1, At, B1); PG8_BAR; PG8_SCHED;
        }
        if constexpr (ALIGN_EPI) { if (wr == 0) PG8_BAR; }
        if constexpr (!Epi::AFTER_DRAIN) { E(acc, cur, wr, wc, fr, fq); }
        if (!has_next) break;
#pragma unroll
        for (int a = 0; a < 2; ++a)
#pragma unroll
            for (int b = 0; b < 2; ++b)
#pragma unroll
                for (int m = 0; m < 4; ++m)
#pragma unroll
                    for (int n = 0; n < 2; ++n) acc[a][b][m][n] = (f32x4){0.f, 0.f, 0.f, 0.f};
        cur = nxt; cA = nA; cB = nB; ++ui;
        if constexpr (ALIGN_EPI) { if (wr == 1) PG8_BAR; }
    }
    PG8_WAIT_V(0);
    if constexpr (!ALIGN_EPI) { if (wr == 0) PG8_BAR; }
    PG8_BAR;
    if constexpr (Epi::AFTER_DRAIN) { E.fused(acc, cur, wr, wc, fr, fq, lds, wid, lane); }
#undef PG8_SA
#undef PG8_SB
#undef PG8_STAGE
#undef PG8_LDA
#undef PG8_LDB
#undef PG8_MMA
#undef PG8_WAIT_V
#undef PG8_WAIT_L
#undef PG8_BAR
#undef PG8_SCHED
}
}

__device__ __forceinline__ void transpose_item(const float* W, int N, bf16_t* WT, int ldt, int k0, int n0, int dest_row0, LAS float* scr, int lane) {
#pragma unroll 8
    for (int i = 0; i < 32; ++i) { const int kk = 2 * i + (lane >> 5); scr[kk * 33 + (lane & 31)] = W[(size_t)(k0 + kk) * N + n0 + (lane & 31)]; }
    LDS_WAIT(); asm volatile("" ::: "memory");
    const int c = lane & 7;
#pragma unroll
    for (int j = 0; j < 4; ++j) { const int n = (lane >> 3) + 8 * j; const LAS float* s = scr + (8 * c) * 33 + n;
        u32x4 o; o.x = cvt_pk_bf16(s[0 * 33], s[1 * 33]); o.y = cvt_pk_bf16(s[2 * 33], s[3 * 33]); o.z = cvt_pk_bf16(s[4 * 33], s[5 * 33]); o.w = cvt_pk_bf16(s[6 * 33], s[7 * 33]);
        *(u32x4*)(WT + (size_t)(dest_row0 + n) * ldt + k0 + 8 * c) = o; }
    LDS_WAIT(); asm volatile("" ::: "memory");
}

__device__ __forceinline__ void transpose_item_ln(const float* W, int N, bf16_t* WT, int ldt, int k0, int n0, int dest_row0, LAS float* scr, int lane, const float* g, const float* b, float* csp_out, float* bwp_out) {
    float csp = 0.f, bwp = 0.f;
#pragma unroll 8
    for (int i = 0; i < 32; ++i) { const int kk = 2 * i + (lane >> 5); const float w = W[(size_t)(k0 + kk) * N + n0 + (lane & 31)], wg = w * g[k0 + kk];
        scr[kk * 33 + (lane & 31)] = wg; csp += wg; bwp += w * b[k0 + kk]; }
    csp += __shfl_xor(csp, 32); bwp += __shfl_xor(bwp, 32);
    if (lane < 32) { csp_out[lane] = csp; bwp_out[lane] = bwp; }
    LDS_WAIT(); asm volatile("" ::: "memory");
    const int c = lane & 7;
#pragma unroll
    for (int j = 0; j < 4; ++j) { const int n = (lane >> 3) + 8 * j; const LAS float* s = scr + (8 * c) * 33 + n;
        u32x4 o; o.x = cvt_pk_bf16(s[0 * 33], s[1 * 33]); o.y = cvt_pk_bf16(s[2 * 33], s[3 * 33]); o.z = cvt_pk_bf16(s[4 * 33], s[5 * 33]); o.w = cvt_pk_bf16(s[6 * 33], s[7 * 33]);
        *(u32x4*)(WT + (size_t)(dest_row0 + n) * ldt + k0 + 8 * c) = o; }
    LDS_WAIT(); asm volatile("" ::: "memory");
}

__device__ __forceinline__ int crow(int r, int hi) { return (r & 3) + 8 * (r >> 2) + 4 * hi; }

__device__ __forceinline__ void load_k(bf16x8 (&kf)[4], const bf16_t* blk) {
#pragma unroll
    for (int s = 0; s < 4; ++s) kf[s] = *(const bf16x8*)(blk + 512 * s);
}
__device__ __forceinline__ void load_v(bf16x8 (&vf)[2][2], const bf16_t* blk) {
#pragma unroll
    for (int db = 0; db < 2; ++db)
#pragma unroll
        for (int s = 0; s < 2; ++s) vf[db][s] = *(const bf16x8*)(blk + 512 * (db * 2 + s));
}
__device__ __forceinline__ bf16x8 pack8(const float* p) {
    const unsigned a = cvt_pk_bf16(p[0], p[1]), b = cvt_pk_bf16(p[2], p[3]), c = cvt_pk_bf16(p[4], p[5]), d = cvt_pk_bf16(p[6], p[7]);
    u32x4 w = {a, b, c, d}; return __builtin_bit_cast(bf16x8, w);
}
__device__ __forceinline__ void rms_store(const f32x16& o0, const f32x16& o1, const float* g, bf16_t* Obase  , int lane, LAS unsigned char* stg) {
    const int q = lane & 31, hi = lane >> 5;
    float ss = 0.f;
#pragma unroll
    for (int r = 0; r < 16; ++r) ss += o0[r] * o0[r] + o1[r] * o1[r];
    ss += __shfl_xor(ss, 32);
    const float rs = 1.0f / sqrtf(ss * (1.0f / 64.0f) + RMS_EPS);
#pragma unroll
    for (int db = 0; db < 2; ++db)
#pragma unroll
        for (int i = 0; i < 4; ++i) { const int d = 32 * db + 8 * i + 4 * hi; const f32x4 gg = *(const f32x4*)(g + d);
            const float a0 = (db ? o1[4 * i + 0] : o0[4 * i + 0]) * rs * gg[0], a1 = (db ? o1[4 * i + 1] : o0[4 * i + 1]) * rs * gg[1];
            const float a2 = (db ? o1[4 * i + 2] : o0[4 * i + 2]) * rs * gg[2], a3 = (db ? o1[4 * i + 3] : o0[4 * i + 3]) * rs * gg[3];
            u32x2 w; w.x = cvt_pk_bf16(a0, a1); w.y = cvt_pk_bf16(a2, a3); *(LAS u32x2*)(stg + q * 144 + d * 2) = w; }
    LDS_WAIT(); asm volatile("" ::: "memory");
#pragma unroll
    for (int k = 0; k < 4; ++k) { const int row = (lane >> 3) + 8 * k, ch = lane & 7;
        const u32x4 w = *(const LAS u32x4*)(stg + row * 144 + ch * 16);
        *(u32x4*)(Obase + (size_t)row * DM + ch * 8) = w; }
    LDS_WAIT(); asm volatile("" ::: "memory");
}

template <bool DIAG>
__device__ __forceinline__ void sb_block(const f32x16& st, float& R, int lim  , int hi, bf16x8& pb0, bf16x8& pb1) {
    float L[16], lb[16];
#pragma unroll
    for (int r = 0; r < 16; ++r) {
        const float z2 = st[r] * (0.125f * LOG2E);
        const float e = fexp2(-fabsf(z2));
        const float l2 = flog2(1.0f + e);
        float b = fminf(z2, 0.f) - l2;
        float l1 = b - z2;
        if (DIAG) { const bool valid = crow(r, hi) < lim; l1 = valid ? l1 : 0.f; b = valid ? b : -INFINITY; }
        L[r] = l1; lb[r] = b;
    }
    float gs[4], pg[4];
#pragma unroll
    for (int i = 0; i < 4; ++i) { gs[i] = (L[4 * i] + L[4 * i + 1]) + (L[4 * i + 2] + L[4 * i + 3]); pg[i] = __shfl_xor(gs[i], 32); }
    float p[16];
    float suf = R;
#pragma unroll
    for (int i = 3; i >= 0; --i) {
        float off = suf + (hi == 0 ? pg[i] : 0.f);
        p[4 * i + 3] = fexp2(lb[4 * i + 3] + off); off += L[4 * i + 3];
        p[4 * i + 2] = fexp2(lb[4 * i + 2] + off); off += L[4 * i + 2];
        p[4 * i + 1] = fexp2(lb[4 * i + 1] + off); off += L[4 * i + 1];
        p[4 * i + 0] = fexp2(lb[4 * i + 0] + off);
        suf += gs[i] + pg[i];
    }
    R = suf;
    pb0 = pack8(p); pb1 = pack8(p + 8);
}

__device__ __forceinline__ void sb_wave(const bf16_t* QK, const bf16_t* VT, bf16_t* O, const float* g_sb, int b, int h, int t0, int lane, LAS unsigned char* stg) {
    const int q = lane & 31, hi = lane >> 5;
    const size_t rowq = (size_t)(b * SEQ + t0 + q);
    const bf16_t* qblk = QK + ((size_t)(b * 52 + 20 + h) * 64) * 2048 + lane * 8;
    const bf16_t* kblk = QK + ((size_t)(b * 52 + 36 + h) * 64) * 2048 + lane * 8;
    const bf16_t* vblk = VT + ((size_t)(b * 20 + 4 + h) * 64) * 2048 + lane * 8;
    bf16x8 qf[4]; load_k(qf, qblk + (size_t)(t0 >> 5) * 2048);
    f32x16 o0, o1;
#pragma unroll
    for (int r = 0; r < 16; ++r) { o0[r] = 0.f; o1[r] = 0.f; }
    float R = 0.f;
    bf16x8 kf[4], kn[4], vf[2][2], pb0, pb1;
    load_k(kf, kblk + (size_t)(t0 >> 5) * 2048);
    for (int k0 = t0; k0 >= 0; k0 -= 32) {
        load_v(vf, vblk + (size_t)(k0 >> 5) * 2048);
        if (k0 >= 32) load_k(kn, kblk + (size_t)((k0 >> 5) - 1) * 2048);
        f32x16 st;
#pragma unroll
        for (int r = 0; r < 16; ++r) st[r] = 0.f;
#pragma unroll
        for (int s = 0; s < 4; ++s) st = __builtin_amdgcn_mfma_f32_32x32x16_bf16(kf[s], qf[s], st, 0, 0, 0);
        if (k0 == t0) sb_block<true>(st, R, q, hi, pb0, pb1); else sb_block<false>(st, R, 64, hi, pb0, pb1);
        o0 = __builtin_amdgcn_mfma_f32_32x32x16_bf16(vf[0][0], pb0, o0, 0, 0, 0);
        o0 = __builtin_amdgcn_mfma_f32_32x32x16_bf16(vf[0][1], pb1, o0, 0, 0, 0);
        o1 = __builtin_amdgcn_mfma_f32_32x32x16_bf16(vf[1][0], pb0, o1, 0, 0, 0);
        o1 = __builtin_amdgcn_mfma_f32_32x32x16_bf16(vf[1][1], pb1, o1, 0, 0, 0);
        if (__all(R < -150.0f)) break;
#pragma unroll
        for (int s = 0; s < 4; ++s) kf[s] = kn[s];
    }
    rms_store(o0, o1, g_sb + h * 64, O + (size_t)(b * SEQ + t0) * DM + 1024 + h * 64, lane, stg);
}

__device__ __forceinline__ void swa_wave(const bf16_t* QK, const bf16_t* VT, bf16_t* O, const float* g_swa, const float* sinks, int b, int hq, int t0, int lane, LAS unsigned char* stg) {
    const int q = lane & 31, hi = lane >> 5, kvh = hq >> 2;
    const size_t rowq = (size_t)(b * SEQ + t0 + q);
    const bf16_t* qblk = QK + ((size_t)(b * 52 + hq) * 64) * 2048 + lane * 8;
    const bf16_t* kblk = QK + ((size_t)(b * 52 + 16 + kvh) * 64) * 2048 + lane * 8;
    const bf16_t* vblk = VT + ((size_t)(b * 20 + kvh) * 64) * 2048 + lane * 8;
    bf16x8 qf[4]; load_k(qf, qblk + (size_t)(t0 >> 5) * 2048);
    const float slope2 = fexp2(-0.5f * (float)(hq + 1)) * LOG2E;
    const float sink2 = sinks[hq] * LOG2E;
    f32x16 st[5];
#pragma unroll
    for (int jb = 0; jb < 5; ++jb) {
        const int k0 = t0 - 128 + 32 * jb;
#pragma unroll
        for (int r = 0; r < 16; ++r) st[jb][r] = 0.f;
        if (k0 >= 0) { bf16x8 kf[4]; load_k(kf, kblk + (size_t)(k0 >> 5) * 2048);
#pragma unroll
            for (int s = 0; s < 4; ++s) st[jb] = __builtin_amdgcn_mfma_f32_32x32x16_bf16(kf[s], qf[s], st[jb], 0, 0, 0); }
    }
    float mx = sink2;
#pragma unroll
    for (int jb = 0; jb < 5; ++jb) {
        const int k0 = t0 - 128 + 32 * jb;
#pragma unroll
        for (int r = 0; r < 16; ++r) { const int dist = q + 128 - 32 * jb - crow(r, hi);
            const bool valid = (k0 >= 0) && (dist >= 0) && (dist < 128);
            const float sc = valid ? (st[jb][r] * (0.125f * LOG2E) - slope2 * (float)dist) : -INFINITY;
            st[jb][r] = sc; mx = fmaxf(mx, sc); }
    }
    mx = fmaxf(mx, __shfl_xor(mx, 32));
    float sum = 0.f;
#pragma unroll
    for (int jb = 0; jb < 5; ++jb)
#pragma unroll
        for (int r = 0; r < 16; ++r) { const float p = fexp2(st[jb][r] - mx); st[jb][r] = p; sum += p; }
    sum += __shfl_xor(sum, 32);
    const float inv = 1.0f / (sum + fexp2(sink2 - mx));
    f32x16 o0, o1;
#pragma unroll
    for (int r = 0; r < 16; ++r) { o0[r] = 0.f; o1[r] = 0.f; }
#pragma unroll
    for (int jb = 0; jb < 5; ++jb) {
        const int k0 = t0 - 128 + 32 * jb;
        if (k0 >= 0) { bf16x8 vf[2][2]; load_v(vf, vblk + (size_t)(k0 >> 5) * 2048);
            float p[16];
#pragma unroll
            for (int r = 0; r < 16; ++r) p[r] = st[jb][r] * inv;
            const bf16x8 pb0 = pack8(p), pb1 = pack8(p + 8);
            o0 = __builtin_amdgcn_mfma_f32_32x32x16_bf16(vf[0][0], pb0, o0, 0, 0, 0);
            o0 = __builtin_amdgcn_mfma_f32_32x32x16_bf16(vf[0][1], pb1, o0, 0, 0, 0);
            o1 = __builtin_amdgcn_mfma_f32_32x32x16_bf16(vf[1][0], pb0, o1, 0, 0, 0);
            o1 = __builtin_amdgcn_mfma_f32_32x32x16_bf16(vf[1][1], pb1, o1, 0, 0, 0); }
    }
    rms_store(o0, o1, g_swa + hq * 64, O + (size_t)(b * SEQ + t0) * DM + hq * 64, lane, stg);
}

__device__ __forceinline__ f32x4 bf4lo(const u32x4& w) { return (f32x4){__builtin_bit_cast(float, w.x << 16), __builtin_bit_cast(float, w.x & 0xffff0000u), __builtin_bit_cast(float, w.y << 16), __builtin_bit_cast(float, w.y & 0xffff0000u)}; }
__device__ __forceinline__ f32x4 bf4hi(const u32x4& w) { return (f32x4){__builtin_bit_cast(float, w.z << 16), __builtin_bit_cast(float, w.z & 0xffff0000u), __builtin_bit_cast(float, w.w << 16), __builtin_bit_cast(float, w.w & 0xffff0000u)}; }
__device__ __forceinline__ void ln_rows(const bf16_t* Y, const float* g, const float* bta, float* Hf, bf16_t* Hb, int gw, int ngw, int lane) {
    for (int row = gw; row < MTOK; row += ngw) {
        const u32x4* yr = (const u32x4*)(Y + (size_t)row * DM) + lane;
        f32x4 v[8]; float s = 0.f;
#pragma unroll
        for (int j = 0; j < 4; ++j) { const u32x4 w = yr[64 * j]; v[2 * j] = bf4lo(w); v[2 * j + 1] = bf4hi(w); }
#pragma unroll
        for (int j = 0; j < 8; ++j) s += (v[j][0] + v[j][1]) + (v[j][2] + v[j][3]);
        const float mean = wave_sum(s) * (1.0f / DM); float s2 = 0.f;
#pragma unroll
        for (int j = 0; j < 8; ++j) { v[j] = v[j] - mean; s2 += (v[j][0] * v[j][0] + v[j][1] * v[j][1]) + (v[j][2] * v[j][2] + v[j][3] * v[j][3]); }
        const float rstd = 1.0f / sqrtf(wave_sum(s2) * (1.0f / DM) + LN_EPS);
#pragma unroll
        for (int j = 0; j < 4; ++j) { const int e = 8 * (lane + 64 * j);
            const f32x4 g0 = *(const f32x4*)(g + e), g1 = *(const f32x4*)(g + e + 4), b0 = *(const f32x4*)(bta + e), b1 = *(const f32x4*)(bta + e + 4);
            const f32x4 o0 = v[2 * j] * rstd * g0 + b0, o1 = v[2 * j + 1] * rstd * g1 + b1;
            if (Hf) { *(f32x4*)(Hf + (size_t)row * DM + e) = o0; *(f32x4*)(Hf + (size_t)row * DM + e + 4) = o1; }
            if (Hb) { u32x4 w; w.x = cvt_pk_bf16(o0[0], o0[1]); w.y = cvt_pk_bf16(o0[2], o0[3]); w.z = cvt_pk_bf16(o1[0], o1[1]); w.w = cvt_pk_bf16(o1[2], o1[3]); *(u32x4*)(Hb + (size_t)row * DM + e) = w; } }
    }
}

#define XB_TMO      128
#define XB_XCNT(j)  (256  + 64 * (j))
#define XB_XSUB(j)  (1280 + 64 * (j))
#define XB_XGEN(j)  (2304 + 64 * (j))
#define XB_TOP      3328
#define XB_TOPGEN   3392
#define XCD_BAR_WORDS 3456
#define XB_SPIN_CAP (1u << 18)

__device__ __forceinline__ unsigned xb_ld(unsigned* p)              { return __hip_atomic_load(p, __ATOMIC_RELAXED, __HIP_MEMORY_SCOPE_AGENT); }
__device__ __forceinline__ unsigned xb_add(unsigned* p, unsigned v) { return __hip_atomic_fetch_add(p, v, __ATOMIC_RELAXED, __HIP_MEMORY_SCOPE_AGENT); }
__device__ __forceinline__ unsigned xb_xcc_id() { return (unsigned)__builtin_amdgcn_s_getreg((3 << 11) | 20) & 0xFu; }
#define XB_SPIN(cond, bar) do { unsigned _sp = 0; while (cond) { __builtin_amdgcn_s_sleep(1); \
    if ((++_sp & 255u) == 0u) { if (xb_ld(&(bar)[XB_TMO])) break; if (_sp > XB_SPIN_CAP) { atomicAdd(&(bar)[XB_TMO], 1u); break; } } } } while (0)

struct XcdBarrier {
    unsigned* bar; unsigned x;
    volatile LAS unsigned* st;
};

__device__ __forceinline__ XcdBarrier xcd_barrier_post(unsigned* bar, volatile LAS unsigned* st) {
    XcdBarrier b; b.bar = bar; b.x = xb_xcc_id(); b.st = st;
    if (threadIdx.x == 0) (void)xb_add(&bar[XB_XCNT(b.x)], 1u);
    return b;
}
__device__ __forceinline__ void xcd_barrier_complete(unsigned* bar, unsigned x, unsigned& nloc, unsigned& nx) {
    const unsigned G = gridDim.x * gridDim.y * gridDim.z;
    unsigned sum, cnt, mine, sp = 0u;
    for (;;) {
        sum = 0u; cnt = 0u; mine = 0u;
#pragma unroll
        for (unsigned j = 0; j < 16; ++j) { const unsigned c = xb_ld(&bar[XB_XCNT(j)]); sum += c; cnt += (c > 0u) ? 1u : 0u; mine = (j == x) ? c : mine; }
        if (sum == G) break;
        __builtin_amdgcn_s_sleep(1);
        if ((++sp & 255u) == 0u) { if (xb_ld(&bar[XB_TMO])) break; if (sp > XB_SPIN_CAP) { atomicAdd(&bar[XB_TMO], 1u); break; } }
    }
    nloc = mine > 0u ? mine : 1u; nx = cnt > 0u ? cnt : 1u;
}

__device__ __forceinline__ void xcd_barrier(const XcdBarrier& b) {
    asm volatile("s_waitcnt vmcnt(0)" ::: "memory");
    __syncthreads();
    if (threadIdx.x == 0) {
        unsigned* bar = b.bar;
        __builtin_amdgcn_s_waitcnt(0);
        unsigned nloc = b.st[0], nx = b.st[1];
        if (nloc == 0u) { xcd_barrier_complete(bar, b.x, nloc, nx); b.st[0] = nloc; b.st[1] = nx; }
        const unsigned old = xb_add(&bar[XB_XSUB(b.x)], 1u);
        const unsigned gen = old / nloc;
        if (old + 1u == (gen + 1u) * nloc) {
            __builtin_amdgcn_fence(__ATOMIC_RELEASE, "agent");
            asm volatile("s_waitcnt vmcnt(0)" ::: "memory");
            const unsigned og = xb_add(&bar[XB_TOP], 1u);
            const unsigned tg = og / nx;
            if (og + 1u == (tg + 1u) * nx) xb_add(&bar[XB_TOPGEN], 1u);
            else XB_SPIN(xb_ld(&bar[XB_TOPGEN]) == tg, bar);
            __builtin_amdgcn_fence(__ATOMIC_ACQUIRE, "agent");
            xb_add(&bar[XB_XGEN(b.x)], 1u);
            asm volatile("s_waitcnt vmcnt(0)" ::: "memory");
        } else {
            XB_SPIN(xb_ld(&bar[XB_XGEN(b.x)]) == gen, bar);
            __builtin_amdgcn_fence(__ATOMIC_ACQUIRE, "agent");
            asm volatile("s_waitcnt vmcnt(0)" ::: "memory");
        }
    }
    __syncthreads();
}


__device__ __forceinline__ void stats_table(const float* Sp, int pm, LAS f32x2* tab, int tid) {
    const int row = tid >> 1, half = tid & 1;
    const float* p = Sp + ((size_t)(half * 16) * MTOK + pm * 256 + row) * 2;
    float s = 0.f, q = 0.f;
#pragma unroll
    for (int j = 0; j < 16; ++j) { const f32x2 v = *(const f32x2*)(p + (size_t)j * MTOK * 2); s += v[0]; q += v[1]; }
    s += __shfl_xor(s, 1); q += __shfl_xor(q, 1);
    const float mean = s * (1.0f / DM), var = q * (1.0f / DM) - mean * mean;
    if (half == 0) tab[row] = (f32x2){mean, 1.0f / sqrtf(var + LN_EPS)};
    __syncthreads();
}

struct Args { const float* in[18]; float* out; unsigned char* ws; int ph_lo, ph_hi; };
constexpr int LDS_BYTES = 147456;

__global__ void __launch_bounds__(512, 2) hymba_fwd(Args a) {
    extern __shared__ __attribute__((aligned(16))) unsigned char lds_raw[];
    LAS unsigned char* lds = (LAS unsigned char*)lds_raw;
    cg::grid_group grid = cg::this_grid();
    const int tid = threadIdx.x, lane = tid & 63, wave = __builtin_amdgcn_readfirstlane(tid >> 6);
    const int G = gridDim.x, c = blockIdx.x;
    const int gw = c * 8 + wave, ngw = G * 8;
    unsigned char* ws = a.ws;
    const float *x = a.in[0], *mem = a.in[1], *w_in = a.in[2], *sinks = a.in[3], *g_swa = a.in[4], *g_sb = a.in[5], *w_o = a.in[6], *ln1_g = a.in[7], *ln1_b = a.in[8],
                *w_q_mem = a.in[9], *w_kv_mem = a.in[10], *w_o_mem = a.in[11], *ln2_g = a.in[12], *ln2_b = a.in[13], *w_gate_up = a.in[14], *w_down = a.in[15], *ln3_g = a.in[16], *ln3_b = a.in[17];
    bf16_t* ALL = (bf16_t*)(ws + WS_ALL);
    bf16_t* Ob = (bf16_t*)(ws + WS_Y + 64 * MiB);
    bf16_t* Hb = ALL;
    bf16_t *QK = (bf16_t*)(ws + WS_QK), *VT = (bf16_t*)(ws + WS_VT), *KM = (bf16_t*)(ws + WS_KM), *VMT = (bf16_t*)(ws + WS_VMT);
    bf16_t *WoT = (bf16_t*)(ws + WS_WO), *WqmT = (bf16_t*)(ws + WS_WQM), *WomT = (bf16_t*)(ws + WS_WOM), *WguT = (bf16_t*)(ws + WS_WGU), *WdT = (bf16_t*)(ws + WS_WD);
    bf16_t *Qm = (bf16_t*)(ws + WS_QM), *Pm = (bf16_t*)(ws + WS_P), *Oc = (bf16_t*)(ws + WS_OC), *Fb = (bf16_t*)(ws + WS_F);
    bf16_t* Yb = (bf16_t*)(ws + WS_Y);
    float *SP1 = (float*)(ws + WS_SP1), *SP2 = (float*)(ws + WS_SP2);
    float *csp = (float*)(ws + WS_CSP), *csf = (float*)(ws + WS_CSF);
    const float *cs1 = csf, *bw1 = csf + NCS, *cs2 = csf + 2048, *bw2 = csf + NCS + 2048;
    LAS f32x2* tab = (LAS f32x2*)(lds + 131072 + 1024);
    float* Hf = a.out;
    const int lo = a.ph_lo, hi_ = a.ph_hi;
    volatile LAS unsigned* xst = (volatile LAS unsigned*)(lds + 131072);
    if (tid == 0) { xst[0] = 0u; xst[1] = 0u; }
    __syncthreads();
    XcdBarrier xbar; xbar.bar = (unsigned*)(ws + WS_CTL); xbar.x = 0; xbar.st = xst;
    if (hi_ - lo > 1) { xbar = xcd_barrier_post((unsigned*)(ws + WS_CTL), xst);
        grid.sync(); }
#ifdef ONLY
#define IN(k) ((k) == ONLY && lo <= (k) && (k) < hi_)
#else
#define IN(k) (lo <= (k) && (k) < hi_)
#endif
#define SEAM(k) do { if (IN(k) && IN((k) + 1)) { xcd_barrier(xbar); } } while (0)
#ifndef REPEAT
#define REPEAT (-1)
#endif
#define REP(k) for (int rep_ = 0; rep_ < ((k) == REPEAT ? 2 : 1); ++rep_, ((k) == REPEAT ? grid.sync() : (void)0))

    if (IN(0)) REP(0) {
        LAS float* scr = (LAS float*)(lds + wave * 16384);
        constexpr int I0 = 32 * 144, I1 = 32 * 128, I2 = 32 * 64, I5 = 32 * 352, I6 = 88 * 64;
        constexpr int NIT = I0 + I1 + 3 * I2 + I5 + I6;
        for (int it = gw; it < NIT; it += ngw) {
            int r = it;
            if (r < I0) { const int kb = r / 144, nb = r % 144; transpose_item(w_in, D_IN, ALL, DM, 64 * kb, 32 * nb, 18432 + 32 * nb, scr, lane); continue; } r -= I0;
            if (r < I1) { const int kb = r / 128, nb = r % 128; transpose_item(w_kv_mem, 4096, ALL, DM, 64 * kb, 32 * nb, 23040 + 32 * nb, scr, lane); continue; } r -= I1;
            if (r < I2) { const int kb = r / 64, nb = r % 64; transpose_item(w_o, DM, WoT, DM, 64 * kb, 32 * nb, 32 * nb, scr, lane); continue; } r -= I2;
            if (r < I2) { const int kb = r / 64, nb = r % 64; transpose_item_ln(w_q_mem, DM, WqmT, DM, 64 * kb, 32 * nb, 32 * nb, scr, lane, ln1_g, ln1_b, csp + (size_t)(kb * 2) * NCS + 32 * nb, csp + (size_t)(kb * 2 + 1) * NCS + 32 * nb); continue; } r -= I2;
            if (r < I2) { const int kb = r / 64, nb = r % 64; transpose_item(w_o_mem, DM, WomT, DM, 64 * kb, 32 * nb, 32 * nb, scr, lane); continue; } r -= I2;
            if (r < I5) { const int kb = r / 352, nb = r % 352; const int n0 = 32 * nb, part = n0 >= D_FF ? 1 : 0, j = n0 - part * D_FF;
                const int dr = 256 * (j >> 7) + 128 * part + (j & 127); transpose_item_ln(w_gate_up, 2 * D_FF, WguT, DM, 64 * kb, n0, dr, scr, lane, ln2_g, ln2_b, csp + (size_t)(kb * 2) * NCS + 2048 + dr, csp + (size_t)(kb * 2 + 1) * NCS + 2048 + dr); continue; } r -= I5;
            { const int kb = r / 64, nb = r % 64; transpose_item(w_down, DM, WdT, D_FF, 64 * kb, 32 * nb, 32 * nb, scr, lane); }
        }
        const size_t nx8 = (size_t)MTOK * DM / 8, nm8 = (size_t)MROWS * DM / 8;
        for (size_t i = (size_t)c * 512 + tid; i < nx8 + nm8; i += (size_t)G * 512) {
            const float* src = i < nx8 ? x + i * 8 : mem + (i - nx8) * 8;
            const f32x4 v0 = *(const f32x4*)src, v1 = *(const f32x4*)(src + 4);
            u32x4 w; w.x = cvt_pk_bf16(v0[0], v0[1]); w.y = cvt_pk_bf16(v0[2], v0[3]); w.z = cvt_pk_bf16(v1[0], v1[1]); w.w = cvt_pk_bf16(v1[2], v1[3]);
            *(u32x4*)(ALL + i * 8) = w;
        }
    }
    SEAM(0);
    if (IN(1)) REP(1) {
        pg8::SchedP1 S{(const char*)ALL, G, c};
        pg8::EpiP1 E{QK, VT, KM, VMT};
        pg8::gemm_phase<pg8::EpiP1, pg8::SchedP1, true>(lds, DM, DM, DM, S, E);
    }
    SEAM(1);
    if (IN(2)) REP(2) {
        if (G == 256) {
            const int pair = c >> 1, b = pair >> 4, h = pair & 15;
#pragma unroll 1
            for (int j = 0; j < 4; ++j) {
                const int qb = (c & 1) ? (j == 0 ? 1 : (j == 1 ? 6 : (j == 2 ? 3 : 4))) : (j == 0 ? 0 : (j == 1 ? 7 : (j == 2 ? 2 : 5)));
                const int w = (j & 1) ? 7 - wave : wave;
                sb_wave(QK, VT, Ob, g_sb, b, h, 256 * qb + 32 * w, lane, lds + wave * 16384);
            }
        } else {
            for (int u = gw; u < NB * 16 * 64; u += ngw) sb_wave(QK, VT, Ob, g_sb, u >> 10, (u >> 6) & 15, 32 * (u & 63), lane, lds + wave * 16384);
        }
        for (int u = gw; u < NB * 16 * 64; u += ngw) swa_wave(QK, VT, Ob, g_swa, sinks, u >> 10, (u >> 6) & 15, 32 * (u & 63), lane, lds + wave * 16384);
    }
    SEAM(2);
    if (IN(3)) {
        for (int i = c * 512 + tid; i < 2 * NCS; i += G * 512) { float acc_ = 0.f;
#pragma unroll 8
            for (int kb = 0; kb < 32; ++kb) acc_ += csp[(size_t)kb * 2 * NCS + i];
            csf[i] = acc_; }
    }
    if (IN(3)) {
        pg8::SchedPlain S; S.init(Ob, DM, WoT, DM, MTOK, DM, G, c);
        pg8::EpiRes<0> E{ALL, Yb, nullptr, nullptr, nullptr, SP1};
        pg8::gemm_phase<pg8::EpiRes<0>, pg8::SchedPlain, true>(lds, DM, DM, DM, S, E);
    }
    SEAM(3);
    if (IN(5)) {
        pg8::SchedPlain S; S.init(Yb, DM, WqmT, DM, MTOK, DM, G, c);
        { pg8::Unit u0; int pm0 = 0; if (S.next(0, u0)) pm0 = u0.pm; stats_table(SP1, pm0, tab, tid); }
        pg8::EpiLnPlain E{Qm, DM, tab, cs1, bw1};
        pg8::gemm_phase<pg8::EpiLnPlain, pg8::SchedPlain, true>(lds, DM, DM, DM, S, E);
    }
    SEAM(5);
    if (IN(6)) {
        pg8::SchedQK S{(const char*)Qm, (const char*)KM, G, c};
        pg8::EpiSoftmax E{Pm};
        pg8::gemm_phase<pg8::EpiSoftmax, pg8::SchedQK, false>(lds, DM, DM, 512, S, E);
    }
    SEAM(6);
    if (IN(7)) {
        pg8::SchedPV S{(const char*)Pm, (const char*)VMT, G, c};
        pg8::EpiPV E{Oc};
        pg8::gemm_phase<pg8::EpiPV, pg8::SchedPV, true>(lds, MEML, MROWS, MEML, S, E);
    }
    SEAM(7);
    if (IN(8)) {
        pg8::SchedPlain S; S.init(Oc, DM, WomT, DM, MTOK, DM, G, c);
        { pg8::Unit u0; int pm0 = 0; if (S.next(0, u0)) pm0 = u0.pm; stats_table(SP1, pm0, tab, tid); }
        pg8::EpiRes<1> E{nullptr, Yb, tab, ln1_g, ln1_b, SP2};
        pg8::gemm_phase<pg8::EpiRes<1>, pg8::SchedPlain, true>(lds, DM, DM, DM, S, E);
    }
    SEAM(8);
    if (IN(10)) {
        pg8::SchedPlain S; S.init(Yb, DM, WguT, DM, MTOK, 2 * D_FF, G, c);
        { pg8::Unit u0; int pm0 = 0; if (S.next(0, u0)) pm0 = u0.pm; stats_table(SP2, pm0, tab, tid); }
        pg8::EpiSwiglu E{Fb, tab, cs2, bw2};
        pg8::gemm_phase<pg8::EpiSwiglu, pg8::SchedPlain, true>(lds, DM, DM, DM, S, E);
    }
    SEAM(10);
    if (IN(11)) {
        pg8::SchedPlain S; S.init(Fb, D_FF, WdT, D_FF, MTOK, DM, G, c);
        { pg8::Unit u0; int pm0 = 0; if (S.next(0, u0)) pm0 = u0.pm; stats_table(SP2, pm0, tab, tid); }
        pg8::EpiRes<2> E{nullptr, Yb, tab, ln2_g, ln2_b, nullptr};
        pg8::gemm_phase<pg8::EpiRes<2>, pg8::SchedPlain, true>(lds, D_FF, D_FF, D_FF, S, E);
    }
    SEAM(11);
    if (IN(12)) ln_rows(Yb, ln3_g, ln3_b, a.out, nullptr, gw, ngw, lane);
#undef IN
#undef SEAM
}

extern "C" void kernel_launch(void* const* d_in, const int* in_sizes, int n_in, void* d_out, int out_size, void* d_ws, size_t ws_size, hipStream_t stream) {
    static int grid = 0;
    if (grid == 0) {
        if (n_in != 18 || in_sizes[0] != MTOK * DM || out_size != MTOK * DM || ws_size < WS_END) {
            fprintf(stderr, "kernel_launch: unexpected shapes / workspace (n_in %d, in0 %d, out %d, ws %zu, need %zu); nothing launched\n", n_in, n_in > 0 ? in_sizes[0] : -1, out_size, ws_size, (size_t)WS_END);
            grid = -1; return; }
        int dev = 0, cus = 0, per_cu = 0;
        hipGetDevice(&dev);
        hipDeviceGetAttribute(&cus, hipDeviceAttributeMultiprocessorCount, dev);
        hipFuncSetAttribute((const void*)hymba_fwd, hipFuncAttributeMaxDynamicSharedMemorySize, LDS_BYTES);
        hipOccupancyMaxActiveBlocksPerMultiprocessor(&per_cu, (const void*)hymba_fwd, 512, LDS_BYTES);
        if (per_cu < 1) { fprintf(stderr, "kernel_launch: occupancy query says %d blocks per CU\n", per_cu); per_cu = 1; }
        grid = cus * 1;
        if (grid != 256) fprintf(stderr, "kernel_launch: %d CUs; P6 needs >= 256 workgroups\n", grid);
    }
    if (grid < 0) return;
    Args a{};
    for (int i = 0; i < 18; ++i) a.in[i] = (const float*)d_in[i];
    a.out = (float*)d_out; a.ws = (unsigned char*)d_ws;
#if MK_MULTI
    for (int p = 0; p < NPHASE; ++p) { a.ph_lo = p; a.ph_hi = p + 1;
        for (int rep = 0; rep < ((PROBE_DUP >> p) & 1 ? 2 : 1); ++rep) hipLaunchKernelGGL(hymba_fwd, dim3(grid), dim3(512), LDS_BYTES, stream, a); }
#else
    a.ph_lo = 0; a.ph_hi = NPHASE;
    (void)hipMemsetAsync((char*)d_ws + WS_CTL, 0, CTL_BYTES, stream);
    void* args[] = {&a};
    hipError_t e = hipLaunchCooperativeKernel((const void*)hymba_fwd, dim3(grid), dim3(512), args, LDS_BYTES, stream);
    if (e != hipSuccess) fprintf(stderr, "cooperative launch failed: %s (grid %d)\n", hipGetErrorString(e), grid);
#endif
}
```
